# Optimizing an MI355X kernel written in HIP

```python
import math
import jax, jax.numpy as jnp
from jax import lax
import numpy as np

D_MODEL = 1024
BATCH = 8
SEQ = 2048
DEPTH = 1
DEC_BATCH = 128
DEC_SEQ = 8
PAST_LEN = 16384
PAGE_SIZE = 128

N_META = 16
CHUNK = 64
CONV_W = 4
RMS_EPS = 1e-6

GDN_HEADS = 4
GDN_DK = 128
GDN_DV = 128
GDN_WIDTH = GDN_HEADS * GDN_DV
GDN_CONV_DIM = GDN_HEADS * (2 * GDN_DK + GDN_DV)

MLSTM_HEADS = 4
MLSTM_DK = 128
MLSTM_DV = 128
MLSTM_WIDTH = MLSTM_HEADS * MLSTM_DV
MLSTM_CONV_DIM = 2 * MLSTM_HEADS * MLSTM_DK

IN_SPLITS = (GDN_HEADS * GDN_DK, GDN_HEADS * GDN_DK, GDN_HEADS * GDN_DV, GDN_HEADS, GDN_HEADS, GDN_HEADS * GDN_DV,
             MLSTM_HEADS * MLSTM_DK, MLSTM_HEADS * MLSTM_DK, MLSTM_HEADS * MLSTM_DV, MLSTM_HEADS, MLSTM_HEADS, MLSTM_HEADS * MLSTM_DV,
             D_MODEL, D_MODEL)
N_IN = 2 * (GDN_HEADS * (2 * GDN_DK + 2 * GDN_DV + 2)) + 2 * D_MODEL

PEER_HEADS = 8
N_KEYS = 128
N_EXPERTS = N_KEYS * N_KEYS
PEER_TOPK = 16
PEER_DQ = 256
KEY_HALF = PEER_DQ // 2
PEER_BLOCK = 128

kernel_name = 'hybrid_gdn_mlstm_peer_step'


def rms_norm(x, gain):
    xf = x.astype(jnp.float32)
    y = xf * lax.rsqrt(jnp.mean(xf * xf, axis=-1, keepdims=True) + RMS_EPS)
    return (y * gain.astype(jnp.float32)).astype(x.dtype)


def l2norm(x):
    return x * lax.rsqrt(jnp.sum(x * x, axis=-1, keepdims=True) + RMS_EPS)


def split_cols(t, sizes):
    offs = np.cumsum(np.array(sizes))[:-1].tolist()
    return jnp.split(t, offs, axis=-1)


def heads(t, n):
    b, l, _ = t.shape
    return t.reshape(b, l, n, -1).transpose(0, 2, 1, 3).astype(jnp.float32)


def causal_conv(ext, w):
    L = ext.shape[1] - (CONV_W - 1)
    y = ext[:, 0:L] * w[0]
    for j in range(1, CONV_W):
        y = y + ext[:, j:j + L] * w[j]
    return y


def gdn_chunked(q, k, v, g, beta, S0, chunk):
    B, H, L, _ = q.shape
    nc = L // chunk

    def blocks(t):
        return t.reshape(B, H, nc, chunk, *t.shape[3:])

    q, k, v, g, beta = blocks(q), blocks(k), blocks(v), blocks(g), blocks(beta)
    G = jnp.cumsum(g, axis=-1)
    incl = jnp.tril(jnp.ones((chunk, chunk), dtype=bool))
    strict = jnp.tril(jnp.ones((chunk, chunk), dtype=bool), k=-1)
    decay = jnp.exp(jnp.where(incl, G[..., :, None] - G[..., None, :], -jnp.inf))
    kk = jnp.einsum('bhnck,bhnsk->bhncs', k, k)
    lhs = jnp.where(strict, beta[..., :, None] * decay * kk, 0.0) + jnp.eye(chunk, dtype=jnp.float32)

    def solve(rhs):
        return lax.linalg.triangular_solve(lhs, rhs, left_side=True, lower=True, unit_diagonal=True)

    u = solve(beta[..., None] * v)
    w = solve((beta * jnp.exp(G))[..., None] * k)
    qk = jnp.einsum('bhnck,bhnsk->bhncs', q, k) * decay
    q_dec = q * jnp.exp(G)[..., None]
    k_end = k * jnp.exp(G[..., -1:] - G)[..., None]
    g_end = jnp.exp(G[..., -1])
    xs = tuple(jnp.moveaxis(t, 2, 0) for t in (u, w, qk, q_dec, k_end, g_end))

    def step(S, inp):
        u_c, w_c, qk_c, qd_c, ke_c, ge_c = inp
        delta = u_c - jnp.einsum('bhck,bhvk->bhcv', w_c, S)
        o = jnp.einsum('bhck,bhvk->bhcv', qd_c, S) + jnp.einsum('bhcs,bhsv->bhcv', qk_c, delta)
        S = ge_c[..., None, None] * S + jnp.einsum('bhsv,bhsk->bhvk', delta, ke_c)
        return S, o

    S, o = lax.scan(step, S0, xs)
    return jnp.moveaxis(o, 0, 2).reshape(B, H, L, -1), S


def mlstm_chunked(q, k, v, logi, logf, C0, n0, m0, chunk):
    B, H, L, _ = q.shape
    nc = L // chunk

    def blocks(t):
        return jnp.moveaxis(t.reshape(B, H, nc, chunk, *t.shape[3:]), 2, 0)

    q, k, v, logi, logf = blocks(q), blocks(k), blocks(v), blocks(logi), blocks(logf)
    F = jnp.cumsum(logf, axis=-1)
    incl = jnp.tril(jnp.ones((chunk, chunk), dtype=bool))
    Dmat = jnp.where(incl, F[..., :, None] - F[..., None, :] + logi[..., None, :], -jnp.inf)
    Dmax = jnp.max(Dmat, axis=-1)
    qk = jnp.einsum('nbhck,nbhsk->nbhcs', q, k)
    F_end = F[..., -1]
    E = F_end[..., None] - F + logi
    E_max = jnp.max(E, axis=-1)

    def step(carry, inp):
        Cs, ns, ms = carry
        q_c, k_c, v_c, F_c, D_c, Dmx, qk_c, Fe, E_c, Emx = inp
        m_inter = F_c + ms[..., None]
        m_t = jnp.maximum(m_inter, Dmx)
        w_intra = jnp.exp(D_c - m_t[..., None]) * qk_c
        w_inter = jnp.exp(m_inter - m_t)
        num = w_inter[..., None] * jnp.einsum('bhck,bhvk->bhcv', q_c, Cs) + jnp.einsum('bhcs,bhsv->bhcv', w_intra, v_c)
        den = w_inter * jnp.einsum('bhck,bhk->bhc', q_c, ns) + jnp.sum(w_intra, axis=-1)
        h = num / jnp.maximum(jnp.abs(den), jnp.exp(-m_t))[..., None]
        m_new = jnp.maximum(Fe + ms, Emx)
        dec = jnp.exp(Fe + ms - m_new)
        wk = jnp.exp(E_c - m_new[..., None])
        Cs = dec[..., None, None] * Cs + jnp.einsum('bhs,bhsv,bhsk->bhvk', wk, v_c, k_c)
        ns = dec[..., None] * ns + jnp.einsum('bhs,bhsk->bhk', wk, k_c)
        return (Cs, ns, m_new), h

    (C, n, m), h = lax.scan(step, (C0, n0, m0), (q, k, v, F, Dmat, Dmax, qk, F_end, E, E_max))
    return jnp.moveaxis(h, 0, 2).reshape(B, H, L, -1), C, n, m


def token_mixers(xn, S0, buf_gdn, C0, n0, m0, buf_mlstm, w_in, conv_gdn, gdn_a_log, gdn_dt_bias, gdn_out_norm,
                 conv_mlstm, mlstm_i_bias, mlstm_f_bias, mlstm_out_norm, w_branch, w_out, n_pad, chunk):
    B, L, _ = xn.shape
    dt = xn.dtype
    f32 = jnp.float32
    proj = jnp.einsum('bld,de->ble', xn, w_in)
    qa, ka, va, a, b, za, qb, kb, vb, ib, fb, ob, ga, gb = split_cols(proj, IN_SPLITS)

    def pad_front(t, value=0.0):
        return jnp.pad(t, [(0, 0), (0, 0), (n_pad, 0)] + [(0, 0)] * (t.ndim - 3), constant_values=value)

    ext_a = jnp.concatenate([buf_gdn.astype(dt), jnp.concatenate([qa, ka, va], axis=-1)], axis=1)
    new_buf_gdn = ext_a[:, L:]
    qkv_a = jax.nn.silu(causal_conv(ext_a, conv_gdn))
    qa, ka, va = jnp.split(qkv_a, [GDN_HEADS * GDN_DK, 2 * GDN_HEADS * GDN_DK], axis=-1)
    qa = l2norm(heads(qa, GDN_HEADS)) * (GDN_DK ** -0.5)
    ka = l2norm(heads(ka, GDN_HEADS))
    va = heads(va, GDN_HEADS)
    g = -jnp.exp(gdn_a_log.astype(f32)) * jax.nn.softplus(a.astype(f32) + gdn_dt_bias.astype(f32))
    beta = jax.nn.sigmoid(b.astype(f32))
    o_a, S_new = gdn_chunked(pad_front(qa), pad_front(ka), pad_front(va), pad_front(g.transpose(0, 2, 1)),
                             pad_front(beta.transpose(0, 2, 1)), S0.astype(f32), chunk)
    o_a = o_a[:, :, n_pad:].transpose(0, 2, 1, 3)
    o_a = rms_norm(o_a, gdn_out_norm) * jax.nn.silu(za.astype(f32)).reshape(B, L, GDN_HEADS, GDN_DV)
    o_a = o_a.reshape(B, L, GDN_WIDTH).astype(dt)

    ext_b = jnp.concatenate([buf_mlstm.astype(dt), jnp.concatenate([qb, kb], axis=-1)], axis=1)
    new_buf_mlstm = ext_b[:, L:]
    qk_b = jax.nn.silu(causal_conv(ext_b, conv_mlstm))
    qb, kb = jnp.split(qk_b, [MLSTM_HEADS * MLSTM_DK], axis=-1)
    qb = heads(qb, MLSTM_HEADS)
    kb = heads(kb, MLSTM_HEADS) * (MLSTM_DK ** -0.5)
    vb = heads(vb, MLSTM_HEADS)
    logi = (ib.astype(f32) + mlstm_i_bias.astype(f32)).transpose(0, 2, 1)
    logf = jax.nn.log_sigmoid(fb.astype(f32) + mlstm_f_bias.astype(f32)).transpose(0, 2, 1)
    o_b, C_new, n_new, m_new = mlstm_chunked(pad_front(qb), pad_front(kb), pad_front(vb), pad_front(logi, -jnp.inf),
                                             pad_front(logf), C0.astype(f32), n0.astype(f32), m0.astype(f32), chunk)
    o_b = o_b[:, :, n_pad:].transpose(0, 2, 1, 3)
    o_b = rms_norm(o_b, mlstm_out_norm).reshape(B, L, MLSTM_WIDTH) * jax.nn.sigmoid(ob.astype(f32))
    o_b = o_b.astype(dt)

    y_a = jnp.einsum('blc,cd->bld', o_a, w_branch[:GDN_WIDTH])
    y_b = jnp.einsum('blc,cd->bld', o_b, w_branch[GDN_WIDTH:])
    merged = jax.nn.sigmoid(ga) * y_a + jax.nn.sigmoid(gb) * y_b
    out = jnp.einsum('bld,de->ble', merged, w_out)
    states = (S_new.astype(S0.dtype), new_buf_gdn.astype(buf_gdn.dtype), C_new.astype(C0.dtype),
              n_new.astype(n0.dtype), m_new.astype(m0.dtype), new_buf_mlstm.astype(buf_mlstm.dtype))
    return out, states


def peer(xn, w_query, sub_keys, expert_u, expert_v):
    B, L, D = xn.shape
    T = B * L
    n_pad = (-T) % PEER_BLOCK
    xt = jnp.pad(xn.reshape(T, D), ((0, n_pad), (0, 0))).reshape(-1, PEER_BLOCK, D)

    def block(xb):
        qh = jnp.einsum('td,de->te', xb, w_query).reshape(PEER_BLOCK, PEER_HEADS, 2, KEY_HALF)
        s = jnp.einsum('thpd,hpnd->thpn', qh, sub_keys).astype(jnp.float32)
        sv, si = lax.top_k(s, PEER_TOPK)
        cand = (sv[:, :, 0, :, None] + sv[:, :, 1, None, :]).reshape(PEER_BLOCK, PEER_HEADS, PEER_TOPK * PEER_TOPK)
        cidx = (si[:, :, 0, :, None] * N_KEYS + si[:, :, 1, None, :]).reshape(PEER_BLOCK, PEER_HEADS, PEER_TOPK * PEER_TOPK)
        top_s, pos = lax.top_k(cand, PEER_TOPK)
        eidx = jnp.take_along_axis(cidx, pos, axis=-1)
        gate = jax.nn.softmax(top_s, axis=-1).astype(xb.dtype)
        act = jax.nn.gelu(jnp.einsum('thkd,td->thk', expert_u[eidx], xb), approximate=False)
        return jnp.einsum('thk,thkd->td', gate * act, expert_v[eidx])

    y = lax.map(block, xt).reshape(-1, D)[:T]
    return y.reshape(B, L, D)


def run_trunk(h, st_gdn_S, st_gdn_conv, st_C, st_n, st_m, st_mconv, norm_mix, w_in, conv_gdn, gdn_a_log, gdn_dt_bias,
              gdn_out_norm, conv_mlstm, mlstm_i_bias, mlstm_f_bias, mlstm_out_norm, w_branch, w_out, norm_ffn,
              peer_w_query, peer_sub_keys, peer_u, peer_v, norm_final, n_pad, chunk, n_drop):
    new = [[] for _ in range(6)]
    for l in range(DEPTH):
        xn = rms_norm(h, norm_mix[l])
        out, states = token_mixers(xn, st_gdn_S[l], st_gdn_conv[l], st_C[l], st_n[l], st_m[l], st_mconv[l],
                                   w_in[l], conv_gdn[l], gdn_a_log[l], gdn_dt_bias[l], gdn_out_norm[l],
                                   conv_mlstm[l], mlstm_i_bias[l], mlstm_f_bias[l], mlstm_out_norm[l],
                                   w_branch[l], w_out[l], n_pad, chunk)
        for lst, s in zip(new, states):
            lst.append(s)
        h = h + out
        if l == DEPTH - 1:
            h = h[:, n_drop:]
        h = h + peer(rms_norm(h, norm_ffn[l]), peer_w_query[l], peer_sub_keys[l], peer_u[l], peer_v[l])
    y = rms_norm(h, norm_final)
    return y, [jnp.stack(lst) for lst in new]


def setup_inputs(seed: int = 0) -> dict:
    key = jax.random.key(seed)
    ks = jax.random.split(key, 32)
    f32 = jnp.float32

    def nrm(k, shape, s):
        return jax.random.normal(k, shape, f32) * s

    dt_init = jnp.exp(jax.random.uniform(ks[13], (DEPTH, GDN_HEADS), f32, math.log(1e-3), math.log(1e-1)))
    return {
        'x_prompt': nrm(ks[0], (BATCH, SEQ, D_MODEL), 1.0),
        'x_sample': nrm(ks[1], (DEC_BATCH, DEC_SEQ, D_MODEL), 1.0),
        'state_gdn_S': nrm(ks[2], (DEPTH, DEC_BATCH, GDN_HEADS, GDN_DV, GDN_DK), 0.1),
        'state_gdn_conv': nrm(ks[3], (DEPTH, DEC_BATCH, CONV_W - 1, GDN_CONV_DIM), 1.0),
        'state_mlstm_C': nrm(ks[4], (DEPTH, DEC_BATCH, MLSTM_HEADS, MLSTM_DV, MLSTM_DK), 0.1),
        'state_mlstm_n': nrm(ks[5], (DEPTH, DEC_BATCH, MLSTM_HEADS, MLSTM_DK), 0.3),
        'state_mlstm_m': nrm(ks[6], (DEPTH, DEC_BATCH, MLSTM_HEADS), 1.0),
        'state_mlstm_conv': nrm(ks[7], (DEPTH, DEC_BATCH, CONV_W - 1, MLSTM_CONV_DIM), 1.0),
        'meta_tokens': nrm(ks[8], (N_META, D_MODEL), 1.0),
        'norm_mix': 1.0 + nrm(ks[9], (DEPTH, D_MODEL), 0.02),
        'w_in': nrm(ks[10], (DEPTH, D_MODEL, N_IN), D_MODEL ** -0.5),
        'conv_gdn': nrm(ks[11], (DEPTH, CONV_W, GDN_CONV_DIM), CONV_W ** -0.5),
        'gdn_a_log': jnp.log(jax.random.uniform(ks[12], (DEPTH, GDN_HEADS), f32, 1.0, 16.0)),
        'gdn_dt_bias': dt_init + jnp.log(-jnp.expm1(-dt_init)),
        'gdn_out_norm': 1.0 + nrm(ks[14], (DEPTH, GDN_DV), 0.02),
        'conv_mlstm': nrm(ks[15], (DEPTH, CONV_W, MLSTM_CONV_DIM), CONV_W ** -0.5),
        'mlstm_i_bias': nrm(ks[16], (DEPTH, MLSTM_HEADS), 0.1),
        'mlstm_f_bias': jnp.linspace(3.0, 6.0, MLSTM_HEADS, dtype=f32)[None] + nrm(ks[17], (DEPTH, MLSTM_HEADS), 0.1),
        'mlstm_out_norm': 1.0 + nrm(ks[18], (DEPTH, MLSTM_HEADS, MLSTM_DV), 0.02),
        'w_branch': nrm(ks[19], (DEPTH, GDN_WIDTH + MLSTM_WIDTH, D_MODEL), GDN_WIDTH ** -0.5),
        'w_out': nrm(ks[20], (DEPTH, D_MODEL, D_MODEL), D_MODEL ** -0.5),
        'norm_ffn': 1.0 + nrm(ks[21], (DEPTH, D_MODEL), 0.02),
        'peer_w_query': nrm(ks[22], (DEPTH, D_MODEL, PEER_HEADS * PEER_DQ), D_MODEL ** -0.5),
        'peer_sub_keys': nrm(ks[23], (DEPTH, PEER_HEADS, 2, N_KEYS, KEY_HALF), KEY_HALF ** -0.5),
        'peer_u': nrm(ks[24], (DEPTH, N_EXPERTS, D_MODEL), D_MODEL ** -0.5),
        'peer_v': nrm(ks[25], (DEPTH, N_EXPERTS, D_MODEL), 0.1),
        'norm_final': 1.0 + nrm(ks[26], (D_MODEL,), 0.02),
    }


def reference(x_prompt, x_sample, state_gdn_S, state_gdn_conv, state_mlstm_C, state_mlstm_n, state_mlstm_m,
              state_mlstm_conv, meta_tokens, norm_mix, w_in, conv_gdn, gdn_a_log, gdn_dt_bias, gdn_out_norm,
              conv_mlstm, mlstm_i_bias, mlstm_f_bias, mlstm_out_norm, w_branch, w_out, norm_ffn, peer_w_query,
              peer_sub_keys, peer_u, peer_v, norm_final):
    weights = (norm_mix, w_in, conv_gdn, gdn_a_log, gdn_dt_bias, gdn_out_norm, conv_mlstm, mlstm_i_bias,
               mlstm_f_bias, mlstm_out_norm, w_branch, w_out, norm_ffn, peer_w_query, peer_sub_keys, peer_u,
               peer_v, norm_final)
    f32 = jnp.float32
    B = x_prompt.shape[0]
    dt = x_prompt.dtype
    sdt = state_gdn_S.dtype
    h_p = jnp.concatenate([jnp.broadcast_to(meta_tokens.astype(dt)[None], (B, N_META, D_MODEL)), x_prompt], axis=1)
    y_prompt, p_states = run_trunk(
        h_p,
        jnp.zeros((DEPTH, B, GDN_HEADS, GDN_DV, GDN_DK), sdt),
        jnp.zeros((DEPTH, B, CONV_W - 1, GDN_CONV_DIM), state_gdn_conv.dtype),
        jnp.zeros((DEPTH, B, MLSTM_HEADS, MLSTM_DV, MLSTM_DK), state_mlstm_C.dtype),
        jnp.zeros((DEPTH, B, MLSTM_HEADS, MLSTM_DK), state_mlstm_n.dtype),
        jnp.zeros((DEPTH, B, MLSTM_HEADS), state_mlstm_m.dtype),
        jnp.zeros((DEPTH, B, CONV_W - 1, MLSTM_CONV_DIM), state_mlstm_conv.dtype),
        *weights, n_pad=CHUNK - N_META, chunk=CHUNK, n_drop=N_META)
    y_sample, s_states = run_trunk(
        x_sample, state_gdn_S, state_gdn_conv, state_mlstm_C, state_mlstm_n, state_mlstm_m, state_mlstm_conv,
        *weights, n_pad=0, chunk=x_sample.shape[1], n_drop=0)
    p_S, p_conv, p_C, p_n, p_m, p_mconv = p_states
    s_S, s_conv, s_C, s_n, s_m, s_mconv = s_states
    return (y_prompt, y_sample, p_S, p_conv, p_C, p_n, p_m, p_mconv, s_S, s_conv, s_C, s_n, s_m, s_mconv)
```

```cpp
#include <hip/hip_runtime.h>
#include <hip/hip_cooperative_groups.h>
#include <cstdio>
#include <cstdint>
namespace cg = cooperative_groups;

#define LAS __attribute__((address_space(3)))
#define PROBE_MODE 0
typedef unsigned short bf16_t;
typedef short bf16x8 __attribute__((ext_vector_type(8)));
typedef float f32x4 __attribute__((ext_vector_type(4)));
typedef unsigned u32x4 __attribute__((ext_vector_type(4)));
typedef unsigned u32x2 __attribute__((ext_vector_type(2)));
typedef float f32x2 __attribute__((ext_vector_type(2)));

constexpr int D = 1024;
constexpr int NTOK = 17536;
constexpr int NPROMPT_TOK = 16512;
constexpr int LP = 2064;
constexpr int NY = 17408;
constexpr int NIN_T = 6272;
constexpr int RESTW = 1536;

constexpr size_t O_Y = 0;
constexpr size_t O_PS = 17825792;
constexpr size_t O_PCONV = O_PS + 524288;
constexpr size_t O_PC = O_PCONV + 36864;
constexpr size_t O_PN = O_PC + 524288;
constexpr size_t O_PM = O_PN + 4096;
constexpr size_t O_PMCONV = O_PM + 32;
constexpr size_t O_SS = O_PMCONV + 24576;
constexpr size_t O_SCONV = O_SS + 8388608;
constexpr size_t O_SC = O_SCONV + 589824;
constexpr size_t O_SN = O_SC + 8388608;
constexpr size_t O_SM = O_SN + 65536;
constexpr size_t O_SMCONV = O_SM + 512;

constexpr size_t OFF_WIN = 0;
constexpr size_t OFF_WB = OFF_WIN + (size_t)NIN_T * 1024 * 2;
constexpr size_t OFF_WO = OFF_WB + 2097152;
constexpr size_t OFF_WQ = OFF_WO + 2097152;
constexpr size_t OFF_KEYS = OFF_WQ + 4194304;
constexpr size_t OFF_ZROW = OFF_KEYS + 524288;
constexpr size_t OFF_RSTD0 = OFF_ZROW + 4096;
constexpr size_t OFF_RSTDH = OFF_RSTD0 + 70144;
constexpr size_t OFF_RSTD2 = OFF_RSTDH + 557056;
constexpr size_t OFF_QKVG = OFF_RSTD2 + 69632;
constexpr size_t OFF_QKM = OFF_QKVG + (size_t)NTOK * 1536 * 2;
constexpr size_t OFF_REST = OFF_QKM + (size_t)NTOK * 1024 * 2;
constexpr size_t OFF_GATES = OFF_REST + (size_t)NTOK * RESTW * 2;
constexpr size_t OFF_ORAW = OFF_GATES + (size_t)NTOK * 16 * 4;
constexpr size_t OFF_MERGED = OFF_ORAW + (size_t)NY * 1024 * 2;
constexpr size_t OFF_SVB = OFF_MERGED + (size_t)NY * 1024 * 2;
constexpr size_t OFF_SIB = OFF_SVB + (size_t)NY * 256 * 2;
constexpr size_t OFF_PUB = OFF_SIB + (size_t)NY * 256;
constexpr size_t OFF_PVB = OFF_PUB + (size_t)16384 * 1024;
constexpr size_t OFF_XNB = OFF_PVB + (size_t)16384 * 1024;
constexpr size_t OFF_BAR = OFF_XNB + (size_t)1152 * 1024 * 2;
constexpr size_t WS_END = OFF_BAR + 256;
static_assert(WS_END <= 320004672ull, "workspace plan exceeds the guaranteed size");

constexpr int LDS_BYTES = 81920;

struct Params {
    const float* in[27];
    float* out;
    unsigned char* ws;
};

__device__ __forceinline__ unsigned cvtpk(float lo, float hi) { unsigned r; asm volatile("v_cvt_pk_bf16_f32 %0, %1, %2" : "=v"(r) : "v"(lo), "v"(hi)); return r; }
typedef __bf16 bf16x2_t __attribute__((ext_vector_type(2)));
__device__ __forceinline__ float dot2bf(unsigned a, unsigned b, float c) { return __builtin_amdgcn_fdot2_f32_bf16(__builtin_bit_cast(bf16x2_t, a), __builtin_bit_cast(bf16x2_t, b), c, false); }
__device__ __forceinline__ float bflo(unsigned u) { return __uint_as_float(u << 16); }
__device__ __forceinline__ float bfhi(unsigned u) { return __uint_as_float(u & 0xffff0000u); }
template <int CTRL> __device__ __forceinline__ float dppf(float x) {
    return __builtin_bit_cast(float, __builtin_amdgcn_mov_dpp(__builtin_bit_cast(int, x), CTRL, 0xf, 0xf, true));
}
__device__ __forceinline__ float row16_sum(float x) { x += dppf<0x128>(x); x += dppf<0x124>(x); x += dppf<0x122>(x); x += dppf<0x121>(x); return x; }
__device__ __forceinline__ float row16_max(float x) { x = fmaxf(x, dppf<0x128>(x)); x = fmaxf(x, dppf<0x124>(x)); x = fmaxf(x, dppf<0x122>(x)); x = fmaxf(x, dppf<0x121>(x)); return x; }
__device__ __forceinline__ float half32_sum(float x) {
    x = row16_sum(x);
    auto s = __builtin_amdgcn_permlane16_swap(__float_as_uint(x), __float_as_uint(x), false, false);
    return __uint_as_float(s[0]) + __uint_as_float(s[1]);
}
__device__ __forceinline__ float wave_sum(float x) {
    x = half32_sum(x);
    auto t = __builtin_amdgcn_permlane32_swap(__float_as_uint(x), __float_as_uint(x), false, false);
    return __uint_as_float(t[0]) + __uint_as_float(t[1]);
}
__device__ __forceinline__ float wave_max(float x) {
    x = row16_max(x);
    auto s = __builtin_amdgcn_permlane16_swap(__float_as_uint(x), __float_as_uint(x), false, false);
    x = fmaxf(__uint_as_float(s[0]), __uint_as_float(s[1]));
    auto t = __builtin_amdgcn_permlane32_swap(__float_as_uint(x), __float_as_uint(x), false, false);
    return fmaxf(__uint_as_float(t[0]), __uint_as_float(t[1]));
}
__device__ __forceinline__ float sigmoidf_(float x) { return 1.f / (1.f + __expf(-x)); }
__device__ __forceinline__ float siluf_(float x) { return x / (1.f + __expf(-x)); }
__device__ __forceinline__ float softplusf_(float x) { return fmaxf(x, 0.f) + log1pf(__expf(-fabsf(x))); }

__device__ __forceinline__ int yrow_to_tok(int yrow) { return yrow < 16384 ? (yrow >> 11) * LP + (yrow & 2047) + 16 : NPROMPT_TOK + (yrow - 16384); }

__device__ __forceinline__ int lds_byte(int r, int c) { int st = (r >> 4) * 2 + (c >> 5), rr = r & 15, cc = c & 31, ob = rr * 64 + cc * 2; return st * 1024 + (ob ^ (((ob >> 9) & 1) << 5)); }
__device__ __forceinline__ void stage_rc(int b, int& R, int& C) { int st = b >> 10, sb = b & 1023, swz = sb ^ (((sb >> 9) & 1) << 5); R = (st >> 1) * 16 + (swz >> 6); C = (st & 1) * 32 + ((swz & 63) >> 1); }

struct ASrc { const void* a[4]; const bf16_t* g[4]; const float* rs[4]; const char* b0; const char* b1; const char* b2; unsigned o0[4], o1[4], o2[4]; };

template <int AMODE, int NT = 4>
__device__ __forceinline__ void gemm_core2(const ASrc& as, const bf16_t* const (&bp)[4], int nk, LAS unsigned char* lds, f32x4 (&acc)[4][NT], int tid) {
    const int wid = tid >> 6, lane = tid & 63, wr = wid >> 1, wc = wid & 1, fr = lane & 15, fq = lane >> 4;
    f32x4 fa[4][2]; u32x4 oa[4], ga[4]; float rsv[4];
#define ISSUE(kt, buf) do { _Pragma("unroll") for (int _i = 0; _i < 4; ++_i) { \
        if (_i < NT) __builtin_amdgcn_global_load_lds((const unsigned*)(bp[_i] + (kt) * 64), (LAS unsigned*)(lds + (buf) * 32768 + 16384 + tid * 16 + _i * 4096), 16, 0, 0); \
        if (AMODE == 0) __builtin_amdgcn_global_load_lds((const unsigned*)((const bf16_t*)as.a[_i] + (kt) * 64), (LAS unsigned*)(lds + (buf) * 32768 + tid * 16 + _i * 4096), 16, 0, 0); \
        if (AMODE == 1) { const float* _s = (const float*)as.a[_i] + (kt) * 64; fa[_i][0] = *(const f32x4*)_s; fa[_i][1] = *(const f32x4*)(_s + 4); } \
        if (AMODE == 2) { oa[_i] = *(const u32x4*)((const bf16_t*)as.a[_i] + (kt) * 64); ga[_i] = *(const u32x4*)(as.g[_i] + (kt) * 64); rsv[_i] = as.rs[_i][(kt) >> 1]; } \
        if (AMODE == 3) { const float* _s = (const float*)(as.b0 + as.o0[_i]) + (kt) * 64; fa[_i][0] = *(const f32x4*)_s; fa[_i][1] = *(const f32x4*)(_s + 4); } \
        if (AMODE == 4) { oa[_i] = *(const u32x4*)((const bf16_t*)(as.b0 + as.o0[_i]) + (kt) * 64); ga[_i] = *(const u32x4*)((const bf16_t*)(as.b1 + as.o1[_i]) + (kt) * 64); rsv[_i] = ((const float*)(as.b2 + as.o2[_i]))[(kt) >> 1]; } } } while (0)
#define WRITEA(buf) do { _Pragma("unroll") for (int _i = 0; _i < 4; ++_i) { u32x4 _w; \
        if (AMODE == 1 || AMODE == 3) { _w[0] = cvtpk(fa[_i][0][0], fa[_i][0][1]); _w[1] = cvtpk(fa[_i][0][2], fa[_i][0][3]); _w[2] = cvtpk(fa[_i][1][0], fa[_i][1][1]); _w[3] = cvtpk(fa[_i][1][2], fa[_i][1][3]); } \
        if (AMODE == 2 || AMODE == 4) { _Pragma("unroll") for (int _q = 0; _q < 4; ++_q) _w[_q] = cvtpk(bflo(oa[_i][_q]) * rsv[_i] * bflo(ga[_i][_q]), bfhi(oa[_i][_q]) * rsv[_i] * bfhi(ga[_i][_q])); } \
        *(LAS u32x4*)(lds + (buf) * 32768 + tid * 16 + _i * 4096) = _w; } } while (0)
    int aoff[2], boff[2];
#pragma unroll
    for (int k = 0; k < 2; ++k) { aoff[k] = lds_byte(wr * 64 + fr, k * 32 + fq * 8); boff[k] = lds_byte(wc * (NT * 16) + fr, k * 32 + fq * 8); }
    __syncthreads();
    ISSUE(0, 0);
    if (AMODE != 0) WRITEA(0);
    for (int t = 0; t < nk; ++t) {
        asm volatile("s_waitcnt vmcnt(0)" ::: "memory");
        __syncthreads();
        if (t + 1 < nk) ISSUE(t + 1, (t + 1) & 1);
        LAS unsigned char* sa = lds + (t & 1) * 32768;
        LAS unsigned char* sb = sa + 16384;
#pragma unroll
        for (int k = 0; k < 2; ++k) {
            bf16x8 af[4], bfr[NT];
#pragma unroll
            for (int m = 0; m < 4; ++m) af[m] = *(const LAS bf16x8*)(sa + aoff[k] + m * 2048);
#pragma unroll
            for (int n = 0; n < NT; ++n) bfr[n] = *(const LAS bf16x8*)(sb + boff[k] + n * 2048);
#pragma unroll
            for (int m = 0; m < 4; ++m)
#pragma unroll
                for (int n = 0; n < NT; ++n) acc[m][n] = __builtin_amdgcn_mfma_f32_16x16x32_bf16(bfr[n], af[m], acc[m][n], 0, 0, 0);
        }
        if (AMODE != 0 && t + 1 < nk) WRITEA((t + 1) & 1);
    }
#undef ISSUE
#undef WRITEA
}
__device__ __forceinline__ int sw4(int x) { return (0x1320 >> (4 * x)) & 3; }
__device__ __forceinline__ void dma4_rc(int tid, int i, int& R, int& C) { const int c = tid + i * 256; R = c >> 2; C = ((c & 3) ^ sw4((R >> 2) & 3)) * 8; }
__device__ __forceinline__ void gemm_core_dma4(const bf16_t* const (&ap)[2], const bf16_t* const (&bp)[2], int nk, LAS unsigned char* lds, f32x4 (&acc)[4][4], int tid) {
    const int wid = tid >> 6, lane = tid & 63, wr = wid >> 1, wc = wid & 1, fr = lane & 15, fq = lane >> 4;
    const int fsw = (fq ^ sw4((fr >> 2) & 3)) * 16;
    const int aoff = (wr * 64 + fr) * 64 + fsw, boff = (wc * 64 + fr) * 64 + fsw;
#define D4_ISSUE(kt) do { const int _st = ((kt) & 3) * 16384; _Pragma("unroll") for (int _i = 0; _i < 2; ++_i) { \
        __builtin_amdgcn_global_load_lds((const unsigned*)(ap[_i] + (kt) * 32), (LAS unsigned*)(lds + _st + tid * 16 + _i * 4096), 16, 0, 0); \
        __builtin_amdgcn_global_load_lds((const unsigned*)(bp[_i] + (kt) * 32), (LAS unsigned*)(lds + _st + 8192 + tid * 16 + _i * 4096), 16, 0, 0); } } while (0)
    asm volatile("s_waitcnt lgkmcnt(0)" ::: "memory");
    __builtin_amdgcn_s_barrier();
    D4_ISSUE(0); D4_ISSUE(1); D4_ISSUE(2);
    for (int t = 0; t < nk; ++t) {
        if (t + 2 < nk) asm volatile("s_waitcnt vmcnt(8)" ::: "memory");
        else if (t + 1 < nk) asm volatile("s_waitcnt vmcnt(4)" ::: "memory");
        else asm volatile("s_waitcnt vmcnt(0)" ::: "memory");
        asm volatile("s_waitcnt lgkmcnt(0)" ::: "memory");
        __builtin_amdgcn_s_barrier();
        asm volatile("" ::: "memory");
        if (t + 3 < nk) D4_ISSUE(t + 3);
        LAS unsigned char* sa = lds + (t & 3) * 16384;
        LAS unsigned char* sb = sa + 8192;
        bf16x8 af[4], bfr[4];
#pragma unroll
        for (int m = 0; m < 4; ++m) af[m] = *(const LAS bf16x8*)(sa + aoff + m * 1024);
#pragma unroll
        for (int n = 0; n < 4; ++n) bfr[n] = *(const LAS bf16x8*)(sb + boff + n * 1024);
#pragma unroll
        for (int m = 0; m < 4; ++m)
#pragma unroll
            for (int n = 0; n < 4; ++n) acc[m][n] = __builtin_amdgcn_mfma_f32_16x16x32_bf16(bfr[n], af[m], acc[m][n], 0, 0, 0);
    }
#undef D4_ISSUE
}
#define ACC_ZERO2(acc) do { _Pragma("unroll") for (int _m = 0; _m < 4; ++_m) _Pragma("unroll") for (int _n = 0; _n < 2; ++_n) acc[_m][_n] = f32x4{0.f, 0.f, 0.f, 0.f}; } while (0)
#define ACC_ZERO(acc) do { _Pragma("unroll") for (int _m = 0; _m < 4; ++_m) _Pragma("unroll") for (int _n = 0; _n < 4; ++_n) acc[_m][_n] = f32x4{0.f, 0.f, 0.f, 0.f}; } while (0)

__device__ __forceinline__ const float* tok_xrow(const Params& p, int g) {
    if (g < 0) return (const float*)(p.ws + OFF_ZROW);
    if (g < NPROMPT_TOK) { const int b = g / LP, t = g - b * LP; return t < 16 ? p.in[8] + t * 1024 : p.in[0] + ((size_t)b * 2048 + (t - 16)) * 1024; }
    return p.in[1] + (size_t)(g - NPROMPT_TOK) * 1024;
}
__device__ __forceinline__ const float* yrow_xrow(const Params& p, int yrow) { return yrow < 16384 ? p.in[0] + (size_t)yrow * 1024 : p.in[1] + (size_t)(yrow - 16384) * 1024; }

__device__ __forceinline__ int win_srccol(int np) {
    if (np < 1536) return np;
    if (np < 2560) return 2056 + (np - 1536);
    if (np < 3072) return 3080 + (np - 2560);
    if (np < 3584) return 1544 + (np - 3072);
    if (np < 4096) return 3600 + (np - 3584);
    if (np < 5120) return 4112 + (np - 4096);
    if (np < 6144) return 5136 + (np - 5120);
    int j = np - 6144;
    if (j < 4) return 1536 + j;
    if (j < 8) return 1540 + (j - 4);
    if (j < 12) return 3592 + (j - 8);
    if (j < 16) return 3596 + (j - 12);
    return -1;
}

__device__ void phase0(const Params& p, LAS unsigned char* lds, int tid) {
    LAS float* tile = (LAS float*)lds;
    for (int u = blockIdx.x; u < 2592; u += gridDim.x) {
        const float* src; bf16_t* dst; int N, nt, kt, wsel; bool remap = false;
        if (u < 1568) { src = p.in[10]; dst = (bf16_t*)(p.ws + OFF_WIN); N = 6160; nt = u >> 4; kt = u & 15; remap = true; wsel = 0; }
        else if (u < 1824) { int v = u - 1568; src = p.in[19]; dst = (bf16_t*)(p.ws + OFF_WB); N = 1024; nt = v >> 4; kt = v & 15; wsel = 1; }
        else if (u < 2080) { int v = u - 1824; src = p.in[20]; dst = (bf16_t*)(p.ws + OFF_WO); N = 1024; nt = v >> 4; kt = v & 15; wsel = 2; }
        else { int v = u - 2080; src = p.in[22]; dst = (bf16_t*)(p.ws + OFF_WQ); N = 2048; nt = v >> 4; kt = v & 15; wsel = 3; }
        const int c = tid & 63, r0 = tid >> 6;
        int sc = nt * 64 + c; if (remap) sc = win_srccol(sc);
        for (int r = r0; r < 64; r += 4) {
            const int k = kt * 64 + r;
            float gk = 1.f;
            if (wsel == 0) gk = p.in[9][k];
            else if (wsel == 1) gk = k < 512 ? p.in[14][k & 127] : p.in[18][k - 512];
            else if (wsel == 3) gk = p.in[21][k];
            tile[r * 65 + c] = sc >= 0 ? src[(size_t)k * N + sc] * gk : 0.f;
        }
        __syncthreads();
        const int cc2 = (tid & 31) * 2, rr0 = tid >> 5;
        for (int rr = rr0; rr < 64; rr += 8) {
            unsigned v = cvtpk(tile[cc2 * 65 + rr], tile[(cc2 + 1) * 65 + rr]);
            *(unsigned*)(dst + (size_t)(nt * 64 + rr) * 1024 + kt * 64 + cc2) = v;
        }
        __syncthreads();
    }
    {
        const float* ks = p.in[23]; bf16_t* kd = (bf16_t*)(p.ws + OFF_KEYS);
        for (int i = (blockIdx.x * 256 + tid) * 4; i < 262144; i += gridDim.x * 256 * 4) {
            f32x4 v = *(const f32x4*)(ks + i);
            u32x2 o; o[0] = cvtpk(v[0], v[1]); o[1] = cvtpk(v[2], v[3]);
            *(u32x2*)(kd + i) = o;
        }
        const size_t NE = (size_t)16384 * 1024, stride = (size_t)gridDim.x * 256 * 16;
        unsigned char* pub = p.ws + OFF_PUB; unsigned char* pvb = p.ws + OFF_PVB;
        for (size_t i = ((size_t)blockIdx.x * 256 + tid) * 16; i < NE; i += stride) {
            u32x4 ou, ov;
#pragma unroll
            for (int q = 0; q < 4; ++q) {
                const f32x4 a = *(const f32x4*)(p.in[24] + i + q * 4), c = *(const f32x4*)(p.in[25] + i + q * 4);
                int w = __builtin_amdgcn_cvt_pk_fp8_f32(fminf(fmaxf(a[0] * 256.f, -448.f), 448.f), fminf(fmaxf(a[1] * 256.f, -448.f), 448.f), 0, false);
                w = __builtin_amdgcn_cvt_pk_fp8_f32(fminf(fmaxf(a[2] * 256.f, -448.f), 448.f), fminf(fmaxf(a[3] * 256.f, -448.f), 448.f), w, true);
                ou[q] = (unsigned)w;
                int z = __builtin_amdgcn_cvt_pk_fp8_f32(fminf(fmaxf(c[0] * 64.f, -448.f), 448.f), fminf(fmaxf(c[1] * 64.f, -448.f), 448.f), 0, false);
                z = __builtin_amdgcn_cvt_pk_fp8_f32(fminf(fmaxf(c[2] * 64.f, -448.f), 448.f), fminf(fmaxf(c[3] * 64.f, -448.f), 448.f), z, true);
                ov[q] = (unsigned)z;
            }
            *(u32x4*)(pub + i) = ou;
            *(u32x4*)(pvb + i) = ov;
        }
    }
    if (blockIdx.x == 0) { float* z = (float*)(p.ws + OFF_ZROW); for (int i = tid; i < 1024; i += 256) z[i] = 0.f; }
    {
        const int lane = tid & 63, gw = blockIdx.x * 4 + (tid >> 6), nw = gridDim.x * 4;
        float* RS0 = (float*)(p.ws + OFF_RSTD0);
        for (int g = gw; g < NTOK; g += nw) {
            const float* src = tok_xrow(p, g);
            bf16_t* dst = g < 16384 ? (bf16_t*)(p.out + O_SS) + (size_t)g * 1024 : (bf16_t*)(p.ws + OFF_XNB) + (size_t)(g - 16384) * 1024;
            float ss = 0.f;
#pragma unroll
            for (int j = 0; j < 4; ++j) {
                f32x4 v = *(const f32x4*)(src + j * 256 + lane * 4); ss += v[0] * v[0] + v[1] * v[1] + v[2] * v[2] + v[3] * v[3];
                u32x2 o; o[0] = cvtpk(v[0], v[1]); o[1] = cvtpk(v[2], v[3]);
                *(u32x2*)(dst + j * 256 + lane * 4) = o;
            }
            ss = wave_sum(ss);
            if (lane == 0) RS0[g] = rsqrtf(ss * (1.f / 1024.f) + 1e-6f);
        }
    }
}

__device__ void phase1(const Params& p, LAS unsigned char* lds, int tid) {
    const float* RS0 = (const float*)(p.ws + OFF_RSTD0);
    const bf16_t* WIN = (const bf16_t*)(p.ws + OFF_WIN);
    bf16_t* QKVG = (bf16_t*)(p.ws + OFF_QKVG);
    bf16_t* QKM = (bf16_t*)(p.ws + OFF_QKM);
    bf16_t* REST = (bf16_t*)(p.ws + OFF_REST);
    float* GATES = (float*)(p.ws + OFF_GATES);
    const int wid = tid >> 6, lane = tid & 63, wr = wid >> 1, wc = wid & 1, fr = lane & 15, fq = lane >> 4;
    int R[4], C[4];
#pragma unroll
    for (int i = 0; i < 4; ++i) stage_rc(tid * 16 + i * 4096, R[i], C[i]);
    LAS float* ctl = (LAS float*)lds;
    LAS float* ssq = (LAS float*)(lds + 66048);
    const bool xmap = (gridDim.x & 7) == 0;
    const int xg = blockIdx.x & 7, xs = blockIdx.x >> 3, xn = gridDim.x >> 3;
    for (int it = xmap ? xs : blockIdx.x; it < (xmap ? 594 : 144 * 33); it += (xmap ? xn : gridDim.x)) {
        int mt, cj;
        if (xmap) { if (it < 576) { mt = it >> 2; cj = xg + 8 * (it & 3); } else { mt = xg + 8 * (it - 576); cj = 32; } }
        else { mt = it / 33; cj = it - mt * 33; }
        const int ct = cj < 32 ? cj : 48;
        const bool sample = mt >= 136;
        const int b = mt / 17, ti = mt - b * 17;
        auto tok_of_row = [&](int r) -> int {
            if (sample) return NPROMPT_TOK + (mt - 136) * 128 + r;
            int t = 125 * ti - 3 + r; return (t >= 0 && t < LP) ? b * LP + t : -1; };
        const bf16_t* ap[2]; const bf16_t* bp[2];
#pragma unroll
        for (int i = 0; i < 2; ++i) {
            int Rr, Cc; dma4_rc(tid, i, Rr, Cc);
            const int g = tok_of_row(Rr);
            const bf16_t* xr = g < 0 ? (const bf16_t*)(p.ws + OFF_ZROW) : (g < 16384 ? (const bf16_t*)(p.out + O_SS) + (size_t)g * 1024 : (const bf16_t*)(p.ws + OFF_XNB) + (size_t)(g - 16384) * 1024);
            ap[i] = xr + Cc; bp[i] = WIN + (size_t)(ct * 128 + Rr) * 1024 + Cc;
        }
        f32x4 acc[4][4];
        ACC_ZERO(acc);
        gemm_core_dma4(ap, bp, 32, lds, acc, tid);
#pragma unroll
        for (int m = 0; m < 4; ++m) {
            const int g = tok_of_row(wr * 64 + m * 16 + fr);
            const float rs = g >= 0 ? RS0[g] : 0.f;
#pragma unroll
            for (int n = 0; n < 4; ++n) acc[m][n] *= rs;
        }
        if (ct < 20) {
            __syncthreads();
#pragma unroll
            for (int m = 0; m < 4; ++m)
#pragma unroll
                for (int n = 0; n < 4; ++n)
#pragma unroll
                    for (int j = 0; j < 4; ++j) ctl[(wr * 64 + m * 16 + fr) * 129 + wc * 64 + n * 16 + fq * 4 + j] = acc[m][n][j];
            __syncthreads();
            const bool gdn = ct < 12; const int cc0 = gdn ? ct * 128 : (ct - 12) * 128; const int CD = gdn ? 1536 : 1024;
            if (!sample && ti == 16) {
                float* dst = p.out + (gdn ? O_PCONV : O_PMCONV) + (size_t)b * 3 * CD;
                for (int idx = tid; idx < 384; idx += 256) { int rr = idx >> 7, c = idx & 127; dst[rr * CD + cc0 + c] = ctl[(64 + rr) * 129 + c]; }
            }
            if (sample) {
                float* dst = p.out + (gdn ? O_SCONV : O_SMCONV);
                for (int idx = tid; idx < 16 * 384; idx += 256) {
                    int s = idx / 384, rem = idx - s * 384, rr = rem >> 7, c = rem & 127, bs = (mt - 136) * 16 + s;
                    dst[((size_t)bs * 3 + rr) * CD + cc0 + c] = ctl[(s * 8 + 5 + rr) * 129 + c];
                }
            }
            {
                const int c = tid & 127, half = tid >> 7;
                const float* cw = gdn ? p.in[11] : p.in[15];
                const float w0 = cw[0 * CD + cc0 + c], w1 = cw[1 * CD + cc0 + c], w2 = cw[2 * CD + cc0 + c], w3 = cw[3 * CD + cc0 + c];
                if (!sample) {
                    const int r0 = half ? 64 : 3, r1 = half ? 128 : 64;
                    float x3 = ctl[(r0 - 3) * 129 + c], x2 = ctl[(r0 - 2) * 129 + c], x1 = ctl[(r0 - 1) * 129 + c];
                    __syncthreads();
                    for (int r = r0; r < r1; ++r) {
                        float x0 = ctl[r * 129 + c];
                        float y = w0 * x3 + w1 * x2 + w2 * x1 + w3 * x0;
                        ctl[r * 129 + c] = siluf_(y);
                        x3 = x2; x2 = x1; x1 = x0;
                    }
                } else {
                    const float* st = gdn ? p.in[3] : p.in[7];
                    __syncthreads();
                    for (int s = half * 8; s < half * 8 + 8; ++s) {
                        const int bs = (mt - 136) * 16 + s;
                        float x3 = st[((size_t)bs * 3 + 0) * CD + cc0 + c], x2 = st[((size_t)bs * 3 + 1) * CD + cc0 + c], x1 = st[((size_t)bs * 3 + 2) * CD + cc0 + c];
                        for (int q = 0; q < 8; ++q) {
                            const int r = s * 8 + q;
                            float x0 = ctl[r * 129 + c];
                            float y = w0 * x3 + w1 * x2 + w2 * x1 + w3 * x0;
                            ctl[r * 129 + c] = siluf_(y);
                            x3 = x2; x2 = x1; x1 = x0;
                        }
                    }
                }
            }
            __syncthreads();
            const int row = tid & 127, hf = tid >> 7;
            float rs = 1.f;
            if (ct < 8) {
                float s = 0.f;
                for (int i = 0; i < 64; ++i) { float v = ctl[row * 129 + hf * 64 + i]; s += v * v; }
                ssq[hf * 128 + row] = s;
                __syncthreads();
                rs = rsqrtf(ssq[row] + ssq[128 + row] + 1e-6f);
                if (ct < 4) rs *= 0.08838834764831845f;
            } else if (ct >= 16) rs = 0.08838834764831845f;
            const int g = tok_of_row(row);
            const bool valid = sample || (row >= 3 && g >= 0);
            if (valid) {
                bf16_t* dst = (gdn ? QKVG + (size_t)g * 1536 : QKM + (size_t)g * 1024) + cc0 + hf * 64;
                for (int i = 0; i < 64; i += 8) {
                    float v[8];
#pragma unroll
                    for (int q = 0; q < 8; ++q) v[q] = ctl[row * 129 + hf * 64 + i + q] * rs;
                    u32x4 o; o[0] = cvtpk(v[0], v[1]); o[1] = cvtpk(v[2], v[3]); o[2] = cvtpk(v[4], v[5]); o[3] = cvtpk(v[6], v[7]);
                    *(u32x4*)(dst + i) = o;
                }
            }
            __syncthreads();
        } else if (ct < 48) {
            const int mode = ct < 24 ? 0 : (ct < 28 ? 1 : 2);
#pragma unroll
            for (int m = 0; m < 4; ++m) {
                const int row = wr * 64 + m * 16 + fr; const int g = tok_of_row(row);
                const bool valid = sample || (row >= 3 && g >= 0);
                if (!valid) continue;
                bf16_t* dst = REST + (size_t)g * RESTW + (ct - 20) * 128 + wc * 64 + fq * 4;
#pragma unroll
                for (int n = 0; n < 4; ++n) {
                    f32x4 v = acc[m][n];
                    if (mode == 1) { for (int j = 0; j < 4; ++j) v[j] = siluf_(v[j]); }
                    else if (mode == 2) { for (int j = 0; j < 4; ++j) v[j] = sigmoidf_(v[j]); }
                    u32x2 o; o[0] = cvtpk(v[0], v[1]); o[1] = cvtpk(v[2], v[3]);
                    *(u32x2*)(dst + n * 16) = o;
                }
            }
        } else {
            if (wc == 0) {
#pragma unroll
                for (int m = 0; m < 4; ++m) {
                    const int row = wr * 64 + m * 16 + fr; const int g = tok_of_row(row);
                    const bool valid = sample || (row >= 3 && g >= 0);
                    if (!valid) continue;
                    f32x4 v = acc[m][0], o;
#pragma unroll
                    for (int j = 0; j < 4; ++j) {
                        float x = v[j], r;
                        if (fq == 0) r = __expf(-__expf(p.in[12][j]) * softplusf_(x + p.in[13][j]));
                        else if (fq == 1) r = sigmoidf_(x);
                        else if (fq == 2) r = x + p.in[16][j];
                        else { float z = x + p.in[17][j]; r = -softplusf_(-z); }
                        o[j] = r;
                    }
                    *(f32x4*)(GATES + (size_t)g * 16 + fq * 4) = o;
                }
            }
        }
    }
}

__device__ __forceinline__ float row8_sum(float x) { x += dppf<0x141>(x); x += dppf<0x4E>(x); x += dppf<0xB1>(x); return x; }

template <int MIX>
__device__ void scan_unit(const Params& p, LAS unsigned char* lds, int tid, int b, int h, int rg, bool sample) {
    const int T = sample ? 8 : LP;
    const size_t g0 = sample ? (size_t)NPROMPT_TOK + b * 8 : (size_t)b * LP;
    const int wave = tid >> 6, lane = tid & 63, rr = lane >> 3, kq = lane & 7;
    const int row32 = wave * 8 + rr, row = rg * 32 + row32;
    const bf16_t* QKVG = (const bf16_t*)(p.ws + OFF_QKVG);
    const bf16_t* QKM = (const bf16_t*)(p.ws + OFF_QKM);
    const bf16_t* REST = (const bf16_t*)(p.ws + OFF_REST);
    const float* GATES = (const float*)(p.ws + OFF_GATES);
    bf16_t* oraw = (bf16_t*)(p.ws + OFF_ORAW);
    f32x2 S[8]; f32x2 n2 = f32x2{0.f, 0.f}; float mrun = 0.f;
#pragma unroll
    for (int i = 0; i < 8; ++i) S[i] = f32x2{0.f, 0.f};
    if (sample) {
        const float* s0 = (MIX == 0 ? p.in[2] : p.in[4]) + ((size_t)(b * 4 + h) * 128 + row) * 128 + kq * 16;
#pragma unroll
        for (int c = 0; c < 4; ++c) { const f32x4 a = *(const f32x4*)(s0 + c * 4); S[c * 2] = f32x2{a[0], a[1]}; S[c * 2 + 1] = f32x2{a[2], a[3]}; }
        if (MIX == 1) {
            const float* n0 = p.in[5] + (size_t)(b * 4 + h) * 128 + kq * 16 + rr * 2;
            n2 = f32x2{n0[0], n0[1]};
            mrun = p.in[6][b * 4 + h];
        }
    }
    LAS float* kbuf = (LAS float*)lds;
    LAS float* qbuf = (LAS float*)(lds + 16384);
    LAS float* vbuf = (LAS float*)(lds + 32768);
    LAS float* g1 = (LAS float*)(lds + 36864);
    LAS float* g2 = (LAS float*)(lds + 36992);
    LAS float* obuf = (LAS float*)(lds + 37120);
    __syncthreads();
    for (int t0 = 0; t0 < T; t0 += 32) {
        const int nt = min(32, T - t0);
        {
            const int tt = tid >> 3, part = tid & 7;
            if (tt < nt) {
                const size_t g = g0 + t0 + tt;
                const bf16_t* qs; const bf16_t* ks;
                if (MIX == 0) { qs = QKVG + g * 1536 + h * 128 + part * 16; ks = qs + 512; }
                else { qs = QKM + g * 1024 + h * 128 + part * 16; ks = qs + 512; }
                u32x4 k0 = *(const u32x4*)ks, k1 = *(const u32x4*)(ks + 8), q0 = *(const u32x4*)qs, q1 = *(const u32x4*)(qs + 8);
                LAS f32x4* kd = (LAS f32x4*)(kbuf + tt * 128 + part * 16);
                LAS f32x4* qd = (LAS f32x4*)(qbuf + tt * 128 + part * 16);
                kd[0] = f32x4{bflo(k0[0]), bfhi(k0[0]), bflo(k0[1]), bfhi(k0[1])}; kd[1] = f32x4{bflo(k0[2]), bfhi(k0[2]), bflo(k0[3]), bfhi(k0[3])};
                kd[2] = f32x4{bflo(k1[0]), bfhi(k1[0]), bflo(k1[1]), bfhi(k1[1])}; kd[3] = f32x4{bflo(k1[2]), bfhi(k1[2]), bflo(k1[3]), bfhi(k1[3])};
                qd[0] = f32x4{bflo(q0[0]), bfhi(q0[0]), bflo(q0[1]), bfhi(q0[1])}; qd[1] = f32x4{bflo(q0[2]), bfhi(q0[2]), bflo(q0[3]), bfhi(q0[3])};
                qd[2] = f32x4{bflo(q1[0]), bfhi(q1[0]), bflo(q1[1]), bfhi(q1[1])}; qd[3] = f32x4{bflo(q1[2]), bfhi(q1[2]), bflo(q1[3]), bfhi(q1[3])};
            }
            if (tid < 128) {
                const int t2 = tid >> 2, hv = tid & 3;
                if (t2 < nt) {
                    const size_t g = g0 + t0 + t2;
                    const bf16_t* vs = (MIX == 0 ? QKVG + g * 1536 + 1024 : REST + g * RESTW) + h * 128 + rg * 32 + hv * 8;
                    u32x4 v0 = *(const u32x4*)vs;
                    LAS f32x4* vd = (LAS f32x4*)(vbuf + t2 * 32 + hv * 8);
                    vd[0] = f32x4{bflo(v0[0]), bfhi(v0[0]), bflo(v0[1]), bfhi(v0[1])}; vd[1] = f32x4{bflo(v0[2]), bfhi(v0[2]), bflo(v0[3]), bfhi(v0[3])};
                }
            } else if (tid < 160) {
                const int t2 = tid - 128;
                if (t2 < nt) { const size_t g = g0 + t0 + t2; g1[t2] = GATES[g * 16 + (MIX ? 8 : 0) + h]; g2[t2] = GATES[g * 16 + (MIX ? 12 : 4) + h]; }
            }
        }
        __syncthreads();
#pragma unroll 2
        for (int tt = 0; tt < nt; ++tt) {
            f32x2 k2[8], q2[8];
#pragma unroll
            for (int c = 0; c < 4; ++c) {
                const f32x4 ka = *(const LAS f32x4*)(kbuf + tt * 128 + kq * 16 + c * 4), qa = *(const LAS f32x4*)(qbuf + tt * 128 + kq * 16 + c * 4);
                k2[c * 2] = f32x2{ka[0], ka[1]}; k2[c * 2 + 1] = f32x2{ka[2], ka[3]};
                q2[c * 2] = f32x2{qa[0], qa[1]}; q2[c * 2 + 1] = f32x2{qa[2], qa[3]};
            }
            const float vt = vbuf[tt * 32 + row32];
            const float ga = g1[tt], gb = g2[tt];
            float o;
            if (MIX == 0) {
                f32x2 pr = S[0] * k2[0], pr2 = S[1] * k2[1];
#pragma unroll
                for (int i = 2; i < 8; i += 2) { pr = S[i] * k2[i] + pr; pr2 = S[i + 1] * k2[i + 1] + pr2; }
                pr = pr + pr2;
                const float r = row8_sum(pr[0] + pr[1]);
                const float coef = gb * (vt - ga * r);
                const f32x2 c2 = f32x2{coef, coef}, a2 = f32x2{ga, ga};
#pragma unroll
                for (int i = 0; i < 8; ++i) S[i] = a2 * S[i] + c2 * k2[i];
                f32x2 po = S[0] * q2[0], po2 = S[1] * q2[1];
#pragma unroll
                for (int i = 2; i < 8; i += 2) { po = S[i] * q2[i] + po; po2 = S[i + 1] * q2[i + 1] + po2; }
                po = po + po2;
                o = row8_sum(po[0] + po[1]);
            } else {
                const float mn = fmaxf(gb + mrun, ga);
                const float fd = __expf(gb + mrun - mn), iw = __expf(ga - mn);
                mrun = mn;
                const float iv = iw * vt;
                const f32x2 f2 = f32x2{fd, fd}, i2 = f32x2{iv, iv}, w2 = f32x2{iw, iw};
                f32x2 pdl;
#pragma unroll
                for (int i = 0; i < 8; ++i) S[i] = f2 * S[i] + i2 * k2[i];
                {
                    const f32x2 kn = *(const LAS f32x2*)(kbuf + tt * 128 + kq * 16 + rr * 2), qn = *(const LAS f32x2*)(qbuf + tt * 128 + kq * 16 + rr * 2);
                    n2 = f2 * n2 + w2 * kn;
                    pdl = n2 * qn;
                }
                f32x2 pn = S[0] * q2[0], pn2 = S[1] * q2[1];
#pragma unroll
                for (int i = 2; i < 8; i += 2) { pn = S[i] * q2[i] + pn; pn2 = S[i + 1] * q2[i + 1] + pn2; }
                pn = pn + pn2;
                const float num = row8_sum(pn[0] + pn[1]), den = wave_sum(pdl[0] + pdl[1]);
                o = num * __builtin_amdgcn_rcpf(fmaxf(fabsf(den), __expf(-mn)));
            }
            obuf[tt * 32 + row32] = o;
        }
        __syncthreads();
        {
            const int tt = tid >> 3, part = tid & 7;
            if (tt < nt) {
                const int t = t0 + tt;
                if (sample || t >= 16) {
                    const size_t yrow = sample ? (size_t)16384 + b * 8 + t : (size_t)b * 2048 + (t - 16);
                    const f32x4 ov = *(const LAS f32x4*)(obuf + tt * 32 + part * 4);
                    u32x2 ow; ow[0] = cvtpk(ov[0], ov[1]); ow[1] = cvtpk(ov[2], ov[3]);
                    *(u32x2*)(oraw + yrow * 1024 + MIX * 512 + h * 128 + rg * 32 + part * 4) = ow;
                }
            }
        }
    }
    {
        float* sd = p.out + (sample ? (MIX == 0 ? O_SS : O_SC) : (MIX == 0 ? O_PS : O_PC)) + ((size_t)(b * 4 + h) * 128 + row) * 128 + kq * 16;
#pragma unroll
        for (int c = 0; c < 4; ++c) *(f32x4*)(sd + c * 4) = f32x4{S[c * 2][0], S[c * 2][1], S[c * 2 + 1][0], S[c * 2 + 1][1]};
        if (MIX == 1 && rg == 0 && wave == 0) {
            float* nd = p.out + (sample ? O_SN : O_PN) + (size_t)(b * 4 + h) * 128 + kq * 16 + rr * 2;
            nd[0] = n2[0]; nd[1] = n2[1];
            if (lane == 0) p.out[(sample ? O_SM : O_PM) + b * 4 + h] = mrun;
        }
    }
    __syncthreads();
}

__device__ void phase2(const Params& p, LAS unsigned char* lds, int tid) {
    auto run_prompt = [&](int u) {
        const int mix = u >> 7, v = u & 127, b = v >> 4, h = (v >> 2) & 3, rg = v & 3;
        if (mix == 0) scan_unit<0>(p, lds, tid, b, h, rg, false); else scan_unit<1>(p, lds, tid, b, h, rg, false);
    };
    auto run_sample = [&](int w) {
        const int mix = w >> 11, v = w & 2047, b = v >> 4, h = (v >> 2) & 3, rg = v & 3;
        if (mix == 0) scan_unit<0>(p, lds, tid, b, h, rg, true); else scan_unit<1>(p, lds, tid, b, h, rg, true);
    };
    if (gridDim.x >= 512) {
        if (blockIdx.x < 256) run_prompt(blockIdx.x);
        else for (int w = blockIdx.x - 256; w < 4096; w += gridDim.x - 256) run_sample(w);
    } else {
        for (int u = blockIdx.x; u < 256 + 4096; u += gridDim.x) { if (u < 256) run_prompt(u); else run_sample(u - 256); }
    }
}

__device__ void phase3(const Params& p, int tid) {
    const int lane = tid & 63, gw = blockIdx.x * 4 + (tid >> 6), nw = gridDim.x * 4;
    const bf16_t* ORAW = (const bf16_t*)(p.ws + OFF_ORAW);
    float* RSH = (float*)(p.ws + OFF_RSTDH);
    for (int yrow = gw; yrow < NY; yrow += nw) {
#pragma unroll
        for (int j = 0; j < 4; ++j) {
            const u32x2 w = *(const u32x2*)(ORAW + (size_t)yrow * 1024 + j * 256 + lane * 4);
            const float a0 = bflo(w[0]), a1 = bfhi(w[0]), a2 = bflo(w[1]), a3 = bfhi(w[1]);
            float ss = a0 * a0 + a1 * a1 + a2 * a2 + a3 * a3;
            ss = half32_sum(ss);
            if ((lane & 31) == 0) RSH[(size_t)yrow * 8 + (j >> 1) * 4 + (j & 1) * 2 + (lane >> 5)] = rsqrtf(ss * (1.f / 128.f) + 1e-6f);
        }
    }
}

__device__ void phase4(const Params& p, LAS unsigned char* lds, int tid) {
    const bf16_t* ORAW = (const bf16_t*)(p.ws + OFF_ORAW);
    const bf16_t* WB = (const bf16_t*)(p.ws + OFF_WB);
    const bf16_t* WIN = (const bf16_t*)(p.ws + OFF_WIN);
    const bf16_t* REST = (const bf16_t*)(p.ws + OFF_REST);
    const float* RS0 = (const float*)(p.ws + OFF_RSTD0);
    const float* RSH = (const float*)(p.ws + OFF_RSTDH);
    bf16_t* MERGED = (bf16_t*)(p.ws + OFF_MERGED);
    const int wid = tid >> 6, lane = tid & 63, wr = wid >> 1, wc = wid & 1, fr = lane & 15, fq = lane >> 4;
    int R[4], C[4];
#pragma unroll
    for (int i = 0; i < 4; ++i) stage_rc(tid * 16 + i * 4096, R[i], C[i]);
    const bool xmap = (gridDim.x & 7) == 0;
    const int xg = blockIdx.x & 7, xs = blockIdx.x >> 3, xn = gridDim.x >> 3;
    for (int it = xmap ? xs : blockIdx.x; it < (xmap ? 272 : 136 * 16); it += (xmap ? xn : gridDim.x)) {
        const int mt = xmap ? (it >> 1) : (it >> 4), ct = xmap ? (xg + 8 * (it & 1)) : (it & 15);
        ASrc ax, ao; const bf16_t* bp[4];
        f32x4 acc[4][2];
        u32x2 pg2[2][4][2];
        LAS u32x4* pal = (LAS u32x4*)(lds + 65536 + tid * 16);
        ax.b0 = (const char*)(mt < 128 ? p.in[0] : p.in[1]);
#pragma unroll
        for (int i = 0; i < 4; ++i) ax.o0[i] = (unsigned)(((mt < 128 ? mt : mt - 128) * 128 + R[i]) * 1024 + C[i]) * 4u;
        ao.b0 = (const char*)ORAW; ao.b1 = (const char*)REST; ao.b2 = (const char*)RSH;
        {
            f32x4 accg[4][4];
#pragma unroll
            for (int i = 0; i < 4; ++i) {
                const int r = R[i], wcg = r >> 6, w = r & 63, gsel = w >> 5, col = wcg * 32 + (w & 31);
                bp[i] = WIN + (size_t)(4096 + gsel * 1024 + ct * 64 + col) * 1024 + C[i];
            }
            ACC_ZERO(accg);
            gemm_core2<3, 4>(ax, bp, 16, lds, accg, tid);
#pragma unroll
            for (int m = 0; m < 4; ++m) {
                const float r0 = RS0[yrow_to_tok(mt * 128 + wr * 64 + m * 16 + fr)];
#pragma unroll
                for (int n = 0; n < 4; ++n) {
                    const f32x4 v = accg[m][n];
                    pg2[n >> 1][m][n & 1][0] = cvtpk(sigmoidf_(v[0] * r0), sigmoidf_(v[1] * r0));
                    pg2[n >> 1][m][n & 1][1] = cvtpk(sigmoidf_(v[2] * r0), sigmoidf_(v[3] * r0));
                }
            }
        }
#pragma unroll
        for (int pass = 0; pass < 2; ++pass) {
#pragma unroll
            for (int i = 0; i < 4; ++i) {
                const int yr = mt * 128 + R[i]; const int g = yrow_to_tok(yr);
                ao.o0[i] = (unsigned)(yr * 1024 + pass * 512 + C[i]) * 2u;
                ao.o1[i] = (unsigned)(g * RESTW + 512 + pass * 512 + C[i]) * 2u;
                ao.o2[i] = (unsigned)(yr * 8 + pass * 4) * 4u;
                bp[i] = WB + (size_t)(ct * 64 + (R[i] & 63)) * 1024 + pass * 512 + C[i];
            }
            ACC_ZERO2(acc);
            gemm_core2<4, 2>(ao, bp, 8, lds, acc, tid);
            if (pass == 0) {
#pragma unroll
                for (int m = 0; m < 4; ++m) {
                    u32x4 w;
#pragma unroll
                    for (int n = 0; n < 2; ++n) {
                        const f32x4 v = acc[m][n];
                        w[n * 2] = cvtpk(v[0] * bflo(pg2[pass][m][n][0]), v[1] * bfhi(pg2[pass][m][n][0]));
                        w[n * 2 + 1] = cvtpk(v[2] * bflo(pg2[pass][m][n][1]), v[3] * bfhi(pg2[pass][m][n][1]));
                    }
                    pal[m * 256] = w;
                }
            } else {
#pragma unroll
                for (int m = 0; m < 4; ++m) {
                    const int yrow = mt * 128 + wr * 64 + m * 16 + fr;
                    bf16_t* dst = MERGED + (size_t)yrow * 1024 + ct * 64 + wc * 32 + fq * 4;
                    const u32x4 w = pal[m * 256];
#pragma unroll
                    for (int n = 0; n < 2; ++n) {
                        const f32x4 v = acc[m][n];
                        u32x2 o;
                        o[0] = cvtpk(bflo(w[n * 2]) + v[0] * bflo(pg2[pass][m][n][0]), bfhi(w[n * 2]) + v[1] * bfhi(pg2[pass][m][n][0]));
                        o[1] = cvtpk(bflo(w[n * 2 + 1]) + v[2] * bflo(pg2[pass][m][n][1]), bfhi(w[n * 2 + 1]) + v[3] * bfhi(pg2[pass][m][n][1]));
                        *(u32x2*)(dst + n * 16) = o;
                    }
                }
            }
        }
    }
}

__device__ void phase5(const Params& p, LAS unsigned char* lds, int tid) {
    const bf16_t* MERGED = (const bf16_t*)(p.ws + OFF_MERGED);
    const bf16_t* WO = (const bf16_t*)(p.ws + OFF_WO);
    float* H2 = p.out + O_Y;
    const int wid = tid >> 6, lane = tid & 63, wr = wid >> 1, wc = wid & 1, fr = lane & 15, fq = lane >> 4;
    int R[4], C[4];
#pragma unroll
    for (int i = 0; i < 4; ++i) stage_rc(tid * 16 + i * 4096, R[i], C[i]);
    for (int tile = blockIdx.x; tile < 136 * 8; tile += gridDim.x) {
        const int mt = tile >> 3, ct = tile & 7;
        const bf16_t* ap[2]; const bf16_t* bp[2];
#pragma unroll
        for (int i = 0; i < 2; ++i) { int Rr, Cc; dma4_rc(tid, i, Rr, Cc); ap[i] = MERGED + (size_t)(mt * 128 + Rr) * 1024 + Cc; bp[i] = WO + (size_t)(ct * 128 + Rr) * 1024 + Cc; }
        f32x4 acc[4][4];
        ACC_ZERO(acc);
        gemm_core_dma4(ap, bp, 32, lds, acc, tid);
#pragma unroll
        for (int m = 0; m < 4; ++m) {
            const int yrow = mt * 128 + wr * 64 + m * 16 + fr;
            const float* hs = yrow_xrow(p, yrow) + ct * 128 + wc * 64 + fq * 4;
            float* dst = H2 + (size_t)yrow * 1024 + ct * 128 + wc * 64 + fq * 4;
#pragma unroll
            for (int n = 0; n < 4; ++n) {
                f32x4 hv = *(const f32x4*)(hs + n * 16);
                f32x4 v = acc[m][n];
                *(f32x4*)(dst + n * 16) = f32x4{hv[0] + v[0], hv[1] + v[1], hv[2] + v[2], hv[3] + v[3]};
            }
        }
    }
}

__device__ void phase5b(const Params& p, int tid) {
    const int lane = tid & 63, gw = blockIdx.x * 4 + (tid >> 6), nw = gridDim.x * 4;
    const float* H2 = p.out + O_Y;
    float* RS2 = (float*)(p.ws + OFF_RSTD2);
    for (int yrow = gw; yrow < NY; yrow += nw) {
        const float* src = H2 + (size_t)yrow * 1024;
        float ss = 0.f;
#pragma unroll
        for (int j = 0; j < 4; ++j) { f32x4 v = *(const f32x4*)(src + j * 256 + lane * 4); ss += v[0] * v[0] + v[1] * v[1] + v[2] * v[2] + v[3] * v[3]; }
        ss = wave_sum(ss);
        if (lane == 0) RS2[yrow] = rsqrtf(ss * (1.f / 1024.f) + 1e-6f);
    }
}

__device__ __forceinline__ void topk16_of_128(float a, float bq, int lane, float& outv, int& outi) {
    unsigned ka = __float_as_uint(a), kb = __float_as_uint(bq);
    ka ^= (ka & 0x80000000u) ? 0xffffffffu : 0x80000000u;
    kb ^= (kb & 0x80000000u) ? 0xffffffffu : 0x80000000u;
    ka = (ka & ~127u) | (unsigned)(127 - lane);
    kb = (kb & ~127u) | (unsigned)(63 - lane);
    unsigned T = 0u;
#pragma unroll 4
    for (int bit = 31; bit >= 0; --bit) {
        const unsigned cand = T | (1u << bit);
        const int cnt = __builtin_popcountll(__ballot(ka >= cand)) + __builtin_popcountll(__ballot(kb >= cand));
        if (cnt >= 16) T = cand;
    }
    unsigned long long ma = __ballot(ka >= T), mb = __ballot(kb >= T);
    unsigned mykey = 0u;
#pragma nounroll
    for (int i = 0; i < 16; ++i) {
        unsigned kj;
        if (ma != 0ull) { const int L = __builtin_ctzll(ma); ma &= ma - 1ull; kj = (unsigned)__builtin_amdgcn_readlane((int)ka, L); }
        else { const int L = __builtin_ctzll(mb); mb &= mb - 1ull; kj = (unsigned)__builtin_amdgcn_readlane((int)kb, L); }
        if (lane == i) mykey = kj;
    }
    int rk = 0;
#pragma unroll
    for (int j = 0; j < 16; ++j) { const unsigned kj = (unsigned)__builtin_amdgcn_readlane((int)mykey, j); rk += (kj > mykey) ? 1 : 0; }
    const int dstl = lane < 16 ? rk : lane;
    const unsigned sk = (unsigned)__builtin_amdgcn_ds_permute(dstl * 4, (int)mykey);
    const unsigned fb = (sk & 0x80000000u) ? (sk ^ 0x80000000u) : ~sk;
    outv = __uint_as_float(fb);
    outi = 127 - (int)(sk & 127u);
}

__device__ void phase6(const Params& p, LAS unsigned char* lds, int tid) {
    const float* H2 = p.out + O_Y;
    const bf16_t* WQ = (const bf16_t*)(p.ws + OFF_WQ);
    const bf16_t* KEYSB = (const bf16_t*)(p.ws + OFF_KEYS);
    const float* RS2 = (const float*)(p.ws + OFF_RSTD2);
    bf16_t* SVB = (bf16_t*)(p.ws + OFF_SVB);
    unsigned char* SIB = (unsigned char*)(p.ws + OFF_SIB);
    const int wid = tid >> 6, lane = tid & 63, wr = wid >> 1, wc = wid & 1, fr = lane & 15, fq = lane >> 4;
    int R[4], C[4];
#pragma unroll
    for (int i = 0; i < 4; ++i) stage_rc(tid * 16 + i * 4096, R[i], C[i]);
    const bool xmap = (gridDim.x & 7) == 0;
    const int xg = blockIdx.x & 7, xs = blockIdx.x >> 3, xn = gridDim.x >> 3;
    for (int it = xmap ? xs : blockIdx.x; it < (xmap ? 272 : 136 * 16); it += (xmap ? xn : gridDim.x)) {
        const int mt = xmap ? (it >> 1) : (it >> 4), hp = xmap ? (xg + 8 * (it & 1)) : (it & 15);
        ASrc as; const bf16_t* bp[4];
#pragma unroll
        for (int i = 0; i < 4; ++i) { as.a[i] = H2 + (size_t)(mt * 128 + R[i]) * 1024 + C[i]; bp[i] = WQ + (size_t)(hp * 128 + R[i]) * 1024 + C[i]; }
        f32x4 acc[4][4];
        ACC_ZERO(acc);
        gemm_core2<1>(as, bp, 16, lds, acc, tid);
        __syncthreads();
#pragma unroll
        for (int m = 0; m < 4; ++m) {
            const int r = wr * 64 + m * 16 + fr;
            const float rs = RS2[mt * 128 + r];
#pragma unroll
            for (int n = 0; n < 4; ++n) {
                const f32x4 v = acc[m][n];
                u32x2 o; o[0] = cvtpk(v[0] * rs, v[1] * rs); o[1] = cvtpk(v[2] * rs, v[3] * rs);
                *(LAS u32x2*)(lds + wc * 32768 + lds_byte(r, n * 16 + fq * 4)) = o;
            }
        }
#pragma unroll
        for (int t = 0; t < 2; ++t)
#pragma unroll
            for (int i = 0; i < 4; ++i)
                __builtin_amdgcn_global_load_lds((const unsigned*)(KEYSB + (size_t)(hp * 128 + R[i]) * 128 + C[i] + t * 64), (LAS unsigned*)(lds + t * 32768 + 16384 + tid * 16 + i * 4096), 16, 0, 0);
        asm volatile("s_waitcnt vmcnt(0)" ::: "memory");
        __syncthreads();
        ACC_ZERO(acc);
        {
            int aoff[2], boff[2];
#pragma unroll
            for (int k = 0; k < 2; ++k) { aoff[k] = lds_byte(wr * 64 + fr, k * 32 + fq * 8); boff[k] = lds_byte(wc * 64 + fr, k * 32 + fq * 8); }
#pragma unroll
            for (int t = 0; t < 2; ++t) {
                LAS unsigned char* sa = lds + t * 32768;
                LAS unsigned char* sb = sa + 16384;
#pragma unroll
                for (int k = 0; k < 2; ++k) {
                    bf16x8 af[4], bfr[4];
#pragma unroll
                    for (int m = 0; m < 4; ++m) af[m] = *(const LAS bf16x8*)(sa + aoff[k] + m * 2048);
#pragma unroll
                    for (int n = 0; n < 4; ++n) bfr[n] = *(const LAS bf16x8*)(sb + boff[k] + n * 2048);
#pragma unroll
                    for (int m = 0; m < 4; ++m)
#pragma unroll
                        for (int n = 0; n < 4; ++n) acc[m][n] = __builtin_amdgcn_mfma_f32_16x16x32_bf16(bfr[n], af[m], acc[m][n], 0, 0, 0);
                }
            }
        }
        __syncthreads();
        LAS float* sct = (LAS float*)lds;
#pragma unroll
        for (int m = 0; m < 4; ++m)
#pragma unroll
            for (int n = 0; n < 4; ++n)
#pragma unroll
                for (int j = 0; j < 4; ++j) sct[(wr * 64 + m * 16 + fr) * 129 + wc * 64 + n * 16 + fq * 4 + j] = acc[m][n][j];
        __syncthreads();
#pragma nounroll
        for (int rr = 0; rr < 32; ++rr) {
            const int row = wid * 32 + rr;
            float ov; int oi;
            topk16_of_128(sct[row * 129 + lane], sct[row * 129 + 64 + lane], lane, ov, oi);
            if (lane < 16) {
                const size_t o = ((size_t)(mt * 128 + row) * 16 + hp) * 16 + lane;
                SVB[o] = (bf16_t)(cvtpk(ov, 0.f) & 0xffffu);
                SIB[o] = (unsigned char)oi;
            }
        }
        __syncthreads();
    }
}

__device__ void phase8(const Params& p, int tid) {
    const int lane = tid & 63, gw = blockIdx.x * 4 + (tid >> 6), nw = gridDim.x * 4;
    float* Y = p.out + O_Y;
    const bf16_t* SVB = (const bf16_t*)(p.ws + OFF_SVB);
    const unsigned char* SIB = (const unsigned char*)(p.ws + OFF_SIB);
    const unsigned char* PUB = p.ws + OFF_PUB;
    const unsigned char* PVB = p.ws + OFF_PVB;
    int ci, cj;
    if (lane < 16) { ci = 0; cj = lane; } else if (lane < 24) { ci = 1; cj = lane - 16; } else if (lane < 29) { ci = 2; cj = lane - 24; } else if (lane < 33) { ci = 3; cj = lane - 29; }
    else if (lane < 36) { ci = 4; cj = lane - 33; } else if (lane < 38) { ci = 5; cj = lane - 36; } else if (lane < 40) { ci = 6; cj = lane - 38; } else if (lane < 42) { ci = 7; cj = lane - 40; }
    else if (lane < 50) { ci = lane - 34; cj = 0; } else { ci = 0; cj = 0; }
    const bool cvalid = lane < 50;
    const int cid = ci * 16 + cj;
    auto select = [&](unsigned sv01, unsigned si01, int& te, float& gate) {
        const float v0 = __uint_as_float(sv01 << 16), v1 = __uint_as_float(sv01 & 0xffff0000u);
        const int i0 = (int)(si01 & 0xffu), i1 = (int)(si01 >> 8);
        const float cv = __shfl(v0, ci) + __shfl(v1, cj);
        const int ecand = __shfl(i0, ci) * 128 + __shfl(i1, cj);
        unsigned key = __float_as_uint(cv);
        key ^= (key & 0x80000000u) ? 0xffffffffu : 0x80000000u;
        key = cvalid ? ((key & ~255u) | (unsigned)(255 - cid)) : 0u;
        int rk = 0;
#pragma unroll 10
        for (int j = 0; j < 50; ++j) { const unsigned kj = (unsigned)__builtin_amdgcn_readlane((int)key, j); rk += (kj > key) ? 1 : 0; }
        const int dstl = cvalid ? rk : lane;
        const unsigned sk = (unsigned)__builtin_amdgcn_ds_permute(dstl * 4, (int)key);
        te = __builtin_amdgcn_ds_permute(dstl * 4, ecand) & 16383;
        const unsigned fb = (sk & 0x80000000u) ? (sk ^ 0x80000000u) : ~sk;
        const float tv = __uint_as_float(fb);
        const float mx = __int_as_float(__builtin_amdgcn_readlane(__float_as_int(tv), 0));
        const float ex = lane < 16 ? __expf(tv - mx) : 0.f;
        gate = ex / wave_sum(ex);
    };
    for (int yrow = gw; yrow < NY; yrow += nw) {
        float* hrow = Y + (size_t)yrow * 1024;
        const size_t svbase = (size_t)yrow * 256 + (lane & 15);
        unsigned svn = (unsigned)SVB[svbase] | ((unsigned)SVB[svbase + 16] << 16);
        unsigned sin_ = (unsigned)SIB[svbase] | ((unsigned)SIB[svbase + 16] << 8);
        float hv[16], x[16], ya[16]; float ss = 0.f;
#pragma unroll
        for (int jj = 0; jj < 2; ++jj) {
            const f32x4 a = *(const f32x4*)(hrow + lane * 16 + jj * 8), b = *(const f32x4*)(hrow + lane * 16 + jj * 8 + 4);
#pragma unroll
            for (int k = 0; k < 4; ++k) { hv[jj * 8 + k] = a[k]; hv[jj * 8 + 4 + k] = b[k]; }
        }
#pragma unroll
        for (int i = 0; i < 16; ++i) { ss += hv[i] * hv[i]; ya[i] = 0.f; }
        ss = wave_sum(ss);
        {
            const float rstd = rsqrtf(ss * (1.f / 1024.f) + 1e-6f);
#pragma unroll
            for (int jj = 0; jj < 2; ++jj) {
                const f32x4 a = *(const f32x4*)(p.in[21] + lane * 16 + jj * 8), b = *(const f32x4*)(p.in[21] + lane * 16 + jj * 8 + 4);
#pragma unroll
                for (int k = 0; k < 4; ++k) { x[jj * 8 + k] = hv[jj * 8 + k] * rstd * a[k]; x[jj * 8 + 4 + k] = hv[jj * 8 + 4 + k] * rstd * b[k]; }
            }
        }
        int te_c; float gate_c;
        select(svn, sin_, te_c, gate_c);
        svn = (unsigned)SVB[svbase + 32] | ((unsigned)SVB[svbase + 48] << 16);
        sin_ = (unsigned)SIB[svbase + 32] | ((unsigned)SIB[svbase + 48] << 8);
#pragma nounroll
        for (int h = 0; h < 8; ++h) {
            int te_n = 0; float gate_n = 0.f;
            {
                u32x4 u0[8], u1[8], vv[8]; float wk[8];
#define LOADROWS(dst, TAB, k0) _Pragma("unroll") for (int g = 0; g < 8; ++g) { const int e = __builtin_amdgcn_readlane(te_c, (k0) + g) & 16383; dst[g] = *(const u32x4*)((TAB) + (size_t)e * 1024 + lane * 16); }
#define DOTS(src, k0) { float dd[8]; \
                    _Pragma("unroll") for (int g = 0; g < 8; ++g) { float d = 0.f; \
                        _Pragma("unroll") for (int q = 0; q < 4; ++q) { const f32x2 lo = __builtin_amdgcn_cvt_pk_f32_fp8((int)src[g][q], false), hi = __builtin_amdgcn_cvt_pk_f32_fp8((int)src[g][q], true); \
                            d += lo[0] * x[q * 4] + lo[1] * x[q * 4 + 1] + hi[0] * x[q * 4 + 2] + hi[1] * x[q * 4 + 3]; } \
                        dd[g] = d; } \
                      \
                    float e4[4], e2[2]; \
                    _Pragma("unroll") for (int j = 0; j < 4; ++j) { auto sw = __builtin_amdgcn_permlane32_swap(__float_as_uint(dd[j]), __float_as_uint(dd[j + 4]), false, false); e4[j] = __uint_as_float(sw[0]) + __uint_as_float(sw[1]); } \
                    _Pragma("unroll") for (int j = 0; j < 2; ++j) { auto sw = __builtin_amdgcn_permlane16_swap(__float_as_uint(e4[j]), __float_as_uint(e4[j + 2]), false, false); e2[j] = __uint_as_float(sw[0]) + __uint_as_float(sw[1]); } \
                    const float t0 = e2[0] + dppf<0x128>(e2[0]), t1 = e2[1] + dppf<0x128>(e2[1]); \
                    float e1 = (lane & 8) ? t1 : t0; \
                    e1 += dppf<0x141>(e1); e1 += dppf<0x4E>(e1); e1 += dppf<0xB1>(e1); \
                    const float dtot = e1 * (1.f / 256.f); \
                    const float act = 0.5f * dtot * (1.f + erff(dtot * 0.70710678118654752f)); \
                    const float wmine = __shfl(gate_c, (k0) + ((lane >> 3) & 7)) * act * (1.f / 64.f); \
                    _Pragma("unroll") for (int g = 0; g < 8; ++g) wk[g] = __int_as_float(__builtin_amdgcn_readlane(__float_as_int(wmine), ((g >> 2) & 1) * 32 + ((g >> 1) & 1) * 16 + (g & 1) * 8)); }
#define ACCUM() _Pragma("unroll") for (int g = 0; g < 8; ++g) { const float w = wk[g]; \
                    _Pragma("unroll") for (int q = 0; q < 4; ++q) { const f32x2 lo = __builtin_amdgcn_cvt_pk_f32_fp8((int)vv[g][q], false), hi = __builtin_amdgcn_cvt_pk_f32_fp8((int)vv[g][q], true); \
                        ya[q * 4] += w * lo[0]; ya[q * 4 + 1] += w * lo[1]; ya[q * 4 + 2] += w * hi[0]; ya[q * 4 + 3] += w * hi[1]; } }
                LOADROWS(u0, PUB, 0)
                if (h < 7) {
                    select(svn, sin_, te_n, gate_n);
                    if (h < 6) {
                        svn = (unsigned)SVB[svbase + (h + 2) * 32] | ((unsigned)SVB[svbase + (h + 2) * 32 + 16] << 16);
                        sin_ = (unsigned)SIB[svbase + (h + 2) * 32] | ((unsigned)SIB[svbase + (h + 2) * 32 + 16] << 8);
                    }
                }
                DOTS(u0, 0)
                LOADROWS(vv, PVB, 0)
                LOADROWS(u1, PUB, 8)
                ACCUM()
                DOTS(u1, 8)
                LOADROWS(vv, PVB, 8)
                ACCUM()
#undef LOADROWS
#undef DOTS
#undef ACCUM
            }
            te_c = te_n; gate_c = gate_n;
        }
        float s2 = 0.f;
#pragma unroll
        for (int jj = 0; jj < 2; ++jj) {
            const f32x4 a = *(const f32x4*)(hrow + lane * 16 + jj * 8), b = *(const f32x4*)(hrow + lane * 16 + jj * 8 + 4);
#pragma unroll
            for (int k = 0; k < 4; ++k) { hv[jj * 8 + k] = a[k] + ya[jj * 8 + k]; hv[jj * 8 + 4 + k] = b[k] + ya[jj * 8 + 4 + k]; }
        }
#pragma unroll
        for (int i = 0; i < 16; ++i) s2 += hv[i] * hv[i];
        s2 = wave_sum(s2);
        const float rstd2 = rsqrtf(s2 * (1.f / 1024.f) + 1e-6f);
#pragma unroll
        for (int jj = 0; jj < 2; ++jj) {
            const f32x4 a = *(const f32x4*)(p.in[26] + lane * 16 + jj * 8), b = *(const f32x4*)(p.in[26] + lane * 16 + jj * 8 + 4);
            *(f32x4*)(hrow + lane * 16 + jj * 8) = f32x4{hv[jj * 8 + 0] * rstd2 * a[0], hv[jj * 8 + 1] * rstd2 * a[1], hv[jj * 8 + 2] * rstd2 * a[2], hv[jj * 8 + 3] * rstd2 * a[3]};
            *(f32x4*)(hrow + lane * 16 + jj * 8 + 4) = f32x4{hv[jj * 8 + 4] * rstd2 * b[0], hv[jj * 8 + 5] * rstd2 * b[1], hv[jj * 8 + 6] * rstd2 * b[2], hv[jj * 8 + 7] * rstd2 * b[3]};
        }
    }
}

__device__ __forceinline__ void grid_barrier(unsigned* ctr, unsigned target) {
    asm volatile("s_waitcnt vmcnt(0)" ::: "memory");
    __syncthreads();
    if (threadIdx.x == 0) {
        __builtin_amdgcn_fence(__ATOMIC_RELEASE, "agent");
        asm volatile("s_waitcnt vmcnt(0)" ::: "memory");
        __hip_atomic_fetch_add(ctr, 1u, __ATOMIC_RELAXED, __HIP_MEMORY_SCOPE_AGENT);
        while (__hip_atomic_load(ctr, __ATOMIC_RELAXED, __HIP_MEMORY_SCOPE_AGENT) < target) __builtin_amdgcn_s_sleep(1);
        __builtin_amdgcn_fence(__ATOMIC_ACQUIRE, "agent");
        asm volatile("s_waitcnt vmcnt(0)" ::: "memory");
    }
    __syncthreads();
}
__device__ __forceinline__ void cg_sync_full(cg::grid_group& grid) {
    asm volatile("s_waitcnt vmcnt(0)" ::: "memory");
    grid.sync();
    if (threadIdx.x == 0) { __builtin_amdgcn_fence(__ATOMIC_ACQUIRE, "agent"); asm volatile("s_waitcnt vmcnt(0)" ::: "memory"); }
    __syncthreads();
}

__global__ void __launch_bounds__(256, 2) fwd_megakernel(Params p) {
    extern __shared__ __attribute__((aligned(16))) unsigned char lds_raw[];
    LAS unsigned char* lds = (LAS unsigned char*)lds_raw;
    cg::grid_group grid = cg::this_grid();
    const int tid = threadIdx.x;
    unsigned* bar = (unsigned*)(p.ws + OFF_BAR);
    const unsigned nb = gridDim.x;
    phase0(p, lds, tid);
    cg_sync_full(grid);
    phase1(p, lds, tid);
    grid_barrier(bar, nb * 1);
    phase2(p, lds, tid);
    grid_barrier(bar, nb * 2);
    phase3(p, tid);
    grid_barrier(bar, nb * 3);
    phase4(p, lds, tid);
    grid_barrier(bar, nb * 4);
    phase5(p, lds, tid);
    grid_barrier(bar, nb * 5);
    phase5b(p, tid);
    grid_barrier(bar, nb * 6);
    phase6(p, lds, tid);
    grid_barrier(bar, nb * 7);
    phase8(p, tid);
}

extern "C" void kernel_launch(void* const* d_in, const int* in_sizes, int n_in, void* d_out, int out_size, void* d_ws, size_t ws_size, hipStream_t stream) {
    static int grid_blocks = 0;
    if (!grid_blocks) {
        int dev = 0, cus = 0, per_cu = 0;
        (void)hipGetDevice(&dev);
        (void)hipDeviceGetAttribute(&cus, hipDeviceAttributeMultiprocessorCount, dev);
        (void)hipFuncSetAttribute((const void*)fwd_megakernel, hipFuncAttributeMaxDynamicSharedMemorySize, LDS_BYTES);
        (void)hipOccupancyMaxActiveBlocksPerMultiprocessor(&per_cu, (const void*)fwd_megakernel, 256, LDS_BYTES);
        if (per_cu > 2) per_cu = 2;
        if (per_cu < 1) per_cu = 1;
        grid_blocks = cus * per_cu;
        if (ws_size < WS_END) fprintf(stderr, "kernel_launch: workspace too small: %zu < %zu\n", ws_size, (size_t)WS_END);
    }
    if (ws_size < WS_END) return;
    Params p{};
    for (int i = 0; i < 27; ++i) p.in[i] = (const float*)d_in[i];
    p.out = (float*)d_out;
    p.ws = (unsigned char*)d_ws;
    (void)hipMemsetAsync((unsigned char*)d_ws + OFF_BAR, 0, 256, stream);
    void* args[] = {&p};
    hipError_t e = hipLaunchCooperativeKernel((const void*)fwd_megakernel, dim3(grid_blocks), dim3(256), args, LDS_BYTES, stream);
    if (e != hipSuccess) fprintf(stderr, "cooperative launch failed: %s (grid %d)\n", hipGetErrorString(e), grid_blocks);
}
```

```cpp
#include <hip/hip_runtime.h>
#include <hip/hip_cooperative_groups.h>
#include <cstdio>
#include <cstdint>
namespace cg = cooperative_groups;

#define LAS __attribute__((address_space(3)))
#define PROBE_MODE 0
typedef unsigned short bf16_t;
typedef short bf16x8 __attribute__((ext_vector_type(8)));
typedef float f32x4 __attribute__((ext_vector_type(4)));
typedef unsigned u32x4 __attribute__((ext_vector_type(4)));
typedef unsigned u32x2 __attribute__((ext_vector_type(2)));
typedef float f32x2 __attribute__((ext_vector_type(2)));

constexpr int D = 1024;
constexpr int NTOK = 17536;
constexpr int NPROMPT_TOK = 16512;
constexpr int LP = 2064;
constexpr int NY = 17408;
constexpr int NIN_T = 6272;
constexpr int RESTW = 1536;

constexpr size_t O_Y = 0;
constexpr size_t O_PS = 17825792;
constexpr size_t O_PCONV = O_PS + 524288;
constexpr size_t O_PC = O_PCONV + 36864;
constexpr size_t O_PN = O_PC + 524288;
constexpr size_t O_PM = O_PN + 4096;
constexpr size_t O_PMCONV = O_PM + 32;
constexpr size_t O_SS = O_PMCONV + 24576;
constexpr size_t O_SCONV = O_SS + 8388608;
constexpr size_t O_SC = O_SCONV + 589824;
constexpr size_t O_SN = O_SC + 8388608;
constexpr size_t O_SM = O_SN + 65536;
constexpr size_t O_SMCONV = O_SM + 512;

constexpr size_t OFF_WIN = 0;
constexpr size_t OFF_WB = OFF_WIN + (size_t)NIN_T * 1024 * 2;
constexpr size_t OFF_WO = OFF_WB + 2097152;
constexpr size_t OFF_WQ = OFF_WO + 2097152;
constexpr size_t OFF_KEYS = OFF_WQ + 4194304;
constexpr size_t OFF_ZROW = OFF_KEYS + 524288;
constexpr size_t OFF_RSTD0 = OFF_ZROW + 4096;
constexpr size_t OFF_RSTDH = OFF_RSTD0 + 70144;
constexpr size_t OFF_RSTD2 = OFF_RSTDH + 557056;
constexpr size_t OFF_QKVG = OFF_RSTD2 + 69632;
constexpr size_t OFF_QKM = OFF_QKVG + (size_t)NTOK * 1536 * 2;
constexpr size_t OFF_REST = OFF_QKM + (size_t)NTOK * 1024 * 2;
constexpr size_t OFF_GATES = OFF_REST + (size_t)NTOK * RESTW * 2;
constexpr size_t OFF_ORAW = OFF_GATES + (size_t)NTOK * 16 * 4;
constexpr size_t OFF_MERGED = OFF_ORAW + (size_t)NY * 1024 * 2;
constexpr size_t OFF_SVB = OFF_MERGED + (size_t)NY * 1024 * 2;
constexpr size_t OFF_SIB = OFF_SVB + (size_t)NY * 256 * 2;
constexpr size_t OFF_PUB = OFF_SIB + (size_t)NY * 256;
constexpr size_t OFF_PVB = OFF_PUB + (size_t)16384 * 1024;
constexpr size_t OFF_XNB = OFF_PVB + (size_t)16384 * 1024;
constexpr size_t OFF_BAR = OFF_XNB + (size_t)1152 * 1024 * 2;
constexpr size_t WS_END = OFF_BAR + 256;
static_assert(WS_END <= 320004672ull, "workspace plan exceeds the guaranteed size");

constexpr int LDS_BYTES = 81920;

struct Params {
    const float* in[27];
    float* out;
    unsigned char* ws;
};

__device__ __forceinline__ unsigned cvtpk(float lo, float hi) { unsigned r; asm volatile("v_cvt_pk_bf16_f32 %0, %1, %2" : "=v"(r) : "v"(lo), "v"(hi)); return r; }
typedef __bf16 bf16x2_t __attribute__((ext_vector_type(2)));
__device__ __forceinline__ float dot2bf(unsigned a, unsigned b, float c) { return __builtin_amdgcn_fdot2_f32_bf16(__builtin_bit_cast(bf16x2_t, a), __builtin_bit_cast(bf16x2_t, b), c, false); }
__device__ __forceinline__ float bflo(unsigned u) { return __uint_as_float(u << 16); }
__device__ __forceinline__ float bfhi(unsigned u) { return __uint_as_float(u & 0xffff0000u); }
template <int CTRL> __device__ __forceinline__ float dppf(float x) {
    return __builtin_bit_cast(float, __builtin_amdgcn_mov_dpp(__builtin_bit_cast(int, x), CTRL, 0xf, 0xf, true));
}
__device__ __forceinline__ float row16_sum(float x) { x += dppf<0x128>(x); x += dppf<0x124>(x); x += dppf<0x122>(x); x += dppf<0x121>(x); return x; }
__device__ __forceinline__ float row16_max(float x) { x = fmaxf(x, dppf<0x128>(x)); x = fmaxf(x, dppf<0x124>(x)); x = fmaxf(x, dppf<0x122>(x)); x = fmaxf(x, dppf<0x121>(x)); return x; }
__device__ __forceinline__ float half32_sum(float x) {
    x = row16_sum(x);
    auto s = __builtin_amdgcn_permlane16_swap(__float_as_uint(x), __float_as_uint(x), false, false);
    return __uint_as_float(s[0]) + __uint_as_float(s[1]);
}
__device__ __forceinline__ float wave_sum(float x) {
    x = half32_sum(x);
    auto t = __builtin_amdgcn_permlane32_swap(__float_as_uint(x), __float_as_uint(x), false, false);
    return __uint_as_float(t[0]) + __uint_as_float(t[1]);
}
__device__ __forceinline__ float wave_max(float x) {
    x = row16_max(x);
    auto s = __builtin_amdgcn_permlane16_swap(__float_as_uint(x), __float_as_uint(x), false, false);
    x = fmaxf(__uint_as_float(s[0]), __uint_as_float(s[1]));
    auto t = __builtin_amdgcn_permlane32_swap(__float_as_uint(x), __float_as_uint(x), false, false);
    return fmaxf(__uint_as_float(t[0]), __uint_as_float(t[1]));
}
__device__ __forceinline__ float sigmoidf_(float x) { return 1.f / (1.f + __expf(-x)); }
__device__ __forceinline__ float siluf_(float x) { return x / (1.f + __expf(-x)); }
__device__ __forceinline__ float softplusf_(float x) { return fmaxf(x, 0.f) + log1pf(__expf(-fabsf(x))); }

__device__ __forceinline__ int yrow_to_tok(int yrow) { return yrow < 16384 ? (yrow >> 11) * LP + (yrow & 2047) + 16 : NPROMPT_TOK + (yrow - 16384); }

__device__ __forceinline__ int lds_byte(int r, int c) { int st = (r >> 4) * 2 + (c >> 5), rr = r & 15, cc = c & 31, ob = rr * 64 + cc * 2; return st * 1024 + (ob ^ (((ob >> 9) & 1) << 5)); }
__device__ __forceinline__ void stage_rc(int b, int& R, int& C) { int st = b >> 10, sb = b & 1023, swz = sb ^ (((sb >> 9) & 1) << 5); R = (st >> 1) * 16 + (swz >> 6); C = (st & 1) * 32 + ((swz & 63) >> 1); }

struct ASrc { const void* a[4]; const bf16_t* g[4]; const float* rs[4]; const char* b0; const char* b1; const char* b2; unsigned o0[4], o1[4], o2[4]; };

template <int AMODE, int NT = 4>
__device__ __forceinline__ void gemm_core2(const ASrc& as, const bf16_t* const (&bp)[4], int nk, LAS unsigned char* lds, f32x4 (&acc)[4][NT], int tid) {
    const int wid = tid >> 6, lane = tid & 63, wr = wid >> 1, wc = wid & 1, fr = lane & 15, fq = lane >> 4;
    f32x4 fa[4][2]; u32x4 oa[4], ga[4]; float rsv[4];
#define ISSUE(kt, buf) do { _Pragma("unroll") for (int _i = 0; _i < 4; ++_i) { \
        if (_i < NT) __builtin_amdgcn_global_load_lds((const unsigned*)(bp[_i] + (kt) * 64), (LAS unsigned*)(lds + (buf) * 32768 + 16384 + tid * 16 + _i * 4096), 16, 0, 0); \
        if (AMODE == 0) __builtin_amdgcn_global_load_lds((const unsigned*)((const bf16_t*)as.a[_i] + (kt) * 64), (LAS unsigned*)(lds + (buf) * 32768 + tid * 16 + _i * 4096), 16, 0, 0); \
        if (AMODE == 1) { const float* _s = (const float*)as.a[_i] + (kt) * 64; fa[_i][0] = *(const f32x4*)_s; fa[_i][1] = *(const f32x4*)(_s + 4); } \
        if (AMODE == 2) { oa[_i] = *(const u32x4*)((const bf16_t*)as.a[_i] + (kt) * 64); ga[_i] = *(const u32x4*)(as.g[_i] + (kt) * 64); rsv[_i] = as.rs[_i][(kt) >> 1]; } \
        if (AMODE == 3) { const float* _s = (const float*)(as.b0 + as.o0[_i]) + (kt) * 64; fa[_i][0] = *(const f32x4*)_s; fa[_i][1] = *(const f32x4*)(_s + 4); } \
        if (AMODE == 4) { oa[_i] = *(const u32x4*)((const bf16_t*)(as.b0 + as.o0[_i]) + (kt) * 64); ga[_i] = *(const u32x4*)((const bf16_t*)(as.b1 + as.o1[_i]) + (kt) * 64); rsv[_i] = ((const float*)(as.b2 + as.o2[_i]))[(kt) >> 1]; } } } while (0)
#define WRITEA(buf) do { _Pragma("unroll") for (int _i = 0; _i < 4; ++_i) { u32x4 _w; \
        if (AMODE == 1 || AMODE == 3) { _w[0] = cvtpk(fa[_i][0][0], fa[_i][0][1]); _w[1] = cvtpk(fa[_i][0][2], fa[_i][0][3]); _w[2] = cvtpk(fa[_i][1][0], fa[_i][1][1]); _w[3] = cvtpk(fa[_i][1][2], fa[_i][1][3]); } \
        if (AMODE == 2 || AMODE == 4) { _Pragma("unroll") for (int _q = 0; _q < 4; ++_q) _w[_q] = cvtpk(bflo(oa[_i][_q]) * rsv[_i] * bflo(ga[_i][_q]), bfhi(oa[_i][_q]) * rsv[_i] * bfhi(ga[_i][_q])); } \
        *(LAS u32x4*)(lds + (buf) * 32768 + tid * 16 + _i * 4096) = _w; } } while (0)
    int aoff[2], boff[2];
#pragma unroll
    for (int k = 0; k < 2; ++k) { aoff[k] = lds_byte(wr * 64 + fr, k * 32 + fq * 8); boff[k] = lds_byte(wc * (NT * 16) + fr, k * 32 + fq * 8); }
    __syncthreads();
    ISSUE(0, 0);
    if (AMODE != 0) WRITEA(0);
    for (int t = 0; t < nk; ++t) {
        asm volatile("s_waitcnt vmcnt(0)" ::: "memory");
        __syncthreads();
        if (t + 1 < nk) ISSUE(t + 1, (t + 1) & 1);
        LAS unsigned char* sa = lds + (t & 1) * 32768;
        LAS unsigned char* sb = sa + 16384;
#pragma unroll
        for (int k = 0; k < 2; ++k) {
            bf16x8 af[4], bfr[NT];
#pragma unroll
            for (int m = 0; m < 4; ++m) af[m] = *(const LAS bf16x8*)(sa + aoff[k] + m * 2048);
#pragma unroll
            for (int n = 0; n < NT; ++n) bfr[n] = *(const LAS bf16x8*)(sb + boff[k] + n * 2048);
#pragma unroll
            for (int m = 0; m < 4; ++m)
#pragma unroll
                for (int n = 0; n < NT; ++n) acc[m][n] = __builtin_amdgcn_mfma_f32_16x16x32_bf16(bfr[n], af[m], acc[m][n], 0, 0, 0);
        }
        if (AMODE != 0 && t + 1 < nk) WRITEA((t + 1) & 1);
    }
#undef ISSUE
#undef WRITEA
}
__device__ __forceinline__ int sw4(int x) { return (0x1320 >> (4 * x)) & 3; }
__device__ __forceinline__ void dma4_rc(int tid, int i, int& R, int& C) { const int c = tid + i * 256; R = c >> 2; C = ((c & 3) ^ sw4((R >> 2) & 3)) * 8; }
__device__ __forceinline__ void gemm_core_dma4(const bf16_t* const (&ap)[2], const bf16_t* const (&bp)[2], int nk, LAS unsigned char* lds, f32x4 (&acc)[4][4], int tid) {
    const int wid = tid >> 6, lane = tid & 63, wr = wid >> 1, wc = wid & 1, fr = lane & 15, fq = lane >> 4;
    const int fsw = (fq ^ sw4((fr >> 2) & 3)) * 16;
    const int aoff = (wr * 64 + fr) * 64 + fsw, boff = (wc * 64 + fr) * 64 + fsw;
#define D4_ISSUE(kt) do { const int _st = ((kt) & 3) * 16384; _Pragma("unroll") for (int _i = 0; _i < 2; ++_i) { \
        __builtin_amdgcn_global_load_lds((const unsigned*)(ap[_i] + (kt) * 32), (LAS unsigned*)(lds + _st + tid * 16 + _i * 4096), 16, 0, 0); \
        __builtin_amdgcn_global_load_lds((const unsigned*)(bp[_i] + (kt) * 32), (LAS unsigned*)(lds + _st + 8192 + tid * 16 + _i * 4096), 16, 0, 0); } } while (0)
    asm volatile("s_waitcnt lgkmcnt(0)" ::: "memory");
    __builtin_amdgcn_s_barrier();
    D4_ISSUE(0); D4_ISSUE(1); D4_ISSUE(2);
    for (int t = 0; t < nk; ++t) {
        if (t + 2 < nk) asm volatile("s_waitcnt vmcnt(8)" ::: "memory");
        else if (t + 1 < nk) asm volatile("s_waitcnt vmcnt(4)" ::: "memory");
        else asm volatile("s_waitcnt vmcnt(0)" ::: "memory");
        asm volatile("s_waitcnt lgkmcnt(0)" ::: "memory");
        __builtin_amdgcn_s_barrier();
        asm volatile("" ::: "memory");
        if (t + 3 < nk) D4_ISSUE(t + 3);
        LAS unsigned char* sa = lds + (t & 3) * 16384;
        LAS unsigned char* sb = sa + 8192;
        bf16x8 af[4], bfr[4];
#pragma unroll
        for (int m = 0; m < 4; ++m) af[m] = *(const LAS bf16x8*)(sa + aoff + m * 1024);
#pragma unroll
        for (int n = 0; n < 4; ++n) bfr[n] = *(const LAS bf16x8*)(sb + boff + n * 1024);
#pragma unroll
        for (int m = 0; m < 4; ++m)
#pragma unroll
            for (int n = 0; n < 4; ++n) acc[m][n] = __builtin_amdgcn_mfma_f32_16x16x32_bf16(bfr[n], af[m], acc[m][n], 0, 0, 0);
    }
#undef D4_ISSUE
}
#define ACC_ZERO2(acc) do { _Pragma("unroll") for (int _m = 0; _m < 4; ++_m) _Pragma("unroll") for (int _n = 0; _n < 2; ++_n) acc[_m][_n] = f32x4{0.f, 0.f, 0.f, 0.f}; } while (0)
#define ACC_ZERO(acc) do { _Pragma("unroll") for (int _m = 0; _m < 4; ++_m) _Pragma("unroll") for (int _n = 0; _n < 4; ++_n) acc[_m][_n] = f32x4{0.f, 0.f, 0.f, 0.f}; } while (0)

__device__ __forceinline__ const float* tok_xrow(const Params& p, int g) {
    if (g < 0) return (const float*)(p.ws + OFF_ZROW);
    if (g < NPROMPT_TOK) { const int b = g / LP, t = g - b * LP; return t < 16 ? p.in[8] + t * 1024 : p.in[0] + ((size_t)b * 2048 + (t - 16)) * 1024; }
    return p.in[1] + (size_t)(g - NPROMPT_TOK) * 1024;
}
__device__ __forceinline__ const float* yrow_xrow(const Params& p, int yrow) { return yrow < 16384 ? p.in[0] + (size_t)yrow * 1024 : p.in[1] + (size_t)(yrow - 16384) * 1024; }

__device__ __forceinline__ int win_srccol(int np) {
    if (np < 1536) return np;
    if (np < 2560) return 2056 + (np - 1536);
    if (np < 3072) return 3080 + (np - 2560);
    if (np < 3584) return 1544 + (np - 3072);
    if (np < 4096) return 3600 + (np - 3584);
    if (np < 5120) return 4112 + (np - 4096);
    if (np < 6144) return 5136 + (np - 5120);
    int j = np - 6144;
    if (j < 4) return 1536 + j;
    if (j < 8) return 1540 + (j - 4);
    if (j < 12) return 3592 + (j - 8);
    if (j < 16) return 3596 + (j - 12);
    return -1;
}

__device__ void phase0(const Params& p, LAS unsigned char* lds, int tid) {
    LAS float* tile = (LAS float*)lds;
    for (int u = blockIdx.x; u < 2592; u += gridDim.x) {
        const float* src; bf16_t* dst; int N, nt, kt, wsel; bool remap = false;
        if (u < 1568) { src = p.in[10]; dst = (bf16_t*)(p.ws + OFF_WIN); N = 6160; nt = u >> 4; kt = u & 15; remap = true; wsel = 0; }
        else if (u < 1824) { int v = u - 1568; src = p.in[19]; dst = (bf16_t*)(p.ws + OFF_WB); N = 1024; nt = v >> 4; kt = v & 15; wsel = 1; }
        else if (u < 2080) { int v = u - 1824; src = p.in[20]; dst = (bf16_t*)(p.ws + OFF_WO); N = 1024; nt = v >> 4; kt = v & 15; wsel = 2; }
        else { int v = u - 2080; src = p.in[22]; dst = (bf16_t*)(p.ws + OFF_WQ); N = 2048; nt = v >> 4; kt = v & 15; wsel = 3; }
        const int c = tid & 63, r0 = tid >> 6;
        int sc = nt * 64 + c; if (remap) sc = win_srccol(sc);
        for (int r = r0; r < 64; r += 4) {
            const int k = kt * 64 + r;
            float gk = 1.f;
            if (wsel == 0) gk = p.in[9][k];
            else if (wsel == 1) gk = k < 512 ? p.in[14][k & 127] : p.in[18][k - 512];
            else if (wsel == 3) gk = p.in[21][k];
            tile[r * 65 + c] = sc >= 0 ? src[(size_t)k * N + sc] * gk : 0.f;
        }
        __syncthreads();
        const int cc2 = (tid & 31) * 2, rr0 = tid >> 5;
        for (int rr = rr0; rr < 64; rr += 8) {
            unsigned v = cvtpk(tile[cc2 * 65 + rr], tile[(cc2 + 1) * 65 + rr]);
            *(unsigned*)(dst + (size_t)(nt * 64 + rr) * 1024 + kt * 64 + cc2) = v;
        }
        __syncthreads();
    }
    {
        const float* ks = p.in[23]; bf16_t* kd = (bf16_t*)(p.ws + OFF_KEYS);
        for (int i = (blockIdx.x * 256 + tid) * 4; i < 262144; i += gridDim.x * 256 * 4) {
            f32x4 v = *(const f32x4*)(ks + i);
            u32x2 o; o[0] = cvtpk(v[0], v[1]); o[1] = cvtpk(v[2], v[3]);
            *(u32x2*)(kd + i) = o;
        }
        const size_t NE = (size_t)16384 * 1024, stride = (size_t)gridDim.x * 256 * 16;
        unsigned char* pub = p.ws + OFF_PUB; unsigned char* pvb = p.ws + OFF_PVB;
        for (size_t i = ((size_t)blockIdx.x * 256 + tid) * 16; i < NE; i += stride) {
            u32x4 ou, ov;
#pragma unroll
            for (int q = 0; q < 4; ++q) {
                const f32x4 a = *(const f32x4*)(p.in[24] + i + q * 4), c = *(const f32x4*)(p.in[25] + i + q * 4);
                int w = __builtin_amdgcn_cvt_pk_fp8_f32(fminf(fmaxf(a[0] * 256.f, -448.f), 448.f), fminf(fmaxf(a[1] * 256.f, -448.f), 448.f), 0, false);
                w = __builtin_amdgcn_cvt_pk_fp8_f32(fminf(fmaxf(a[2] * 256.f, -448.f), 448.f), fminf(fmaxf(a[3] * 256.f, -448.f), 448.f), w, true);
                ou[q] = (unsigned)w;
                int z = __builtin_amdgcn_cvt_pk_fp8_f32(fminf(fmaxf(c[0] * 64.f, -448.f), 448.f), fminf(fmaxf(c[1] * 64.f, -448.f), 448.f), 0, false);
                z = __builtin_amdgcn_cvt_pk_fp8_f32(fminf(fmaxf(c[2] * 64.f, -448.f), 448.f), fminf(fmaxf(c[3] * 64.f, -448.f), 448.f), z, true);
                ov[q] = (unsigned)z;
            }
            *(u32x4*)(pub + i) = ou;
            *(u32x4*)(pvb + i) = ov;
        }
    }
    if (blockIdx.x == 0) { float* z = (float*)(p.ws + OFF_ZROW); for (int i = tid; i < 1024; i += 256) z[i] = 0.f; }
    {
        const int lane = tid & 63, gw = blockIdx.x * 4 + (tid >> 6), nw = gridDim.x * 4;
        float* RS0 = (float*)(p.ws + OFF_RSTD0);
        for (int g = gw; g < NTOK; g += nw) {
            const float* src = tok_xrow(p, g);
            bf16_t* dst = g < 16384 ? (bf16_t*)(p.out + O_SS) + (size_t)g * 1024 : (bf16_t*)(p.ws + OFF_XNB) + (size_t)(g - 16384) * 1024;
            float ss = 0.f;
#pragma unroll
            for (int j = 0; j < 4; ++j) {
                f32x4 v = *(const f32x4*)(src + j * 256 + lane * 4); ss += v[0] * v[0] + v[1] * v[1] + v[2] * v[2] + v[3] * v[3];
                u32x2 o; o[0] = cvtpk(v[0], v[1]); o[1] = cvtpk(v[2], v[3]);
                *(u32x2*)(dst + j * 256 + lane * 4) = o;
            }
            ss = wave_sum(ss);
            if (lane == 0) RS0[g] = rsqrtf(ss * (1.f / 1024.f) + 1e-6f);
        }
    }
}

__device__ void phase1(const Params& p, LAS unsigned char* lds, int tid) {
    const float* RS0 = (const float*)(p.ws + OFF_RSTD0);
    const bf16_t* WIN = (const bf16_t*)(p.ws + OFF_WIN);
    bf16_t* QKVG = (bf16_t*)(p.ws + OFF_QKVG);
    bf16_t* QKM = (bf16_t*)(p.ws + OFF_QKM);
    bf16_t* REST = (bf16_t*)(p.ws + OFF_REST);
    float* GATES = (float*)(p.ws + OFF_GATES);
    const int wid = tid >> 6, lane = tid & 63, wr = wid >> 1, wc = wid & 1, fr = lane & 15, fq = lane >> 4;
    int R[4], C[4];
#pragma unroll
    for (int i = 0; i < 4; ++i) stage_rc(tid * 16 + i * 4096, R[i], C[i]);
    LAS float* ctl = (LAS float*)lds;
    LAS float* ssq = (LAS float*)(lds + 66048);
    const bool xmap = (gridDim.x & 7) == 0;
    const int xg = blockIdx.x & 7, xs = blockIdx.x >> 3, xn = gridDim.x >> 3;
    for (int it = xmap ? xs : blockIdx.x; it < (xmap ? 594 : 144 * 33); it += (xmap ? xn : gridDim.x)) {
        int mt, cj;
        if (xmap) { if (it < 576) { mt = it >> 2; cj = xg + 8 * (it & 3); } else { mt = xg + 8 * (it - 576); cj = 32; } }
        else { mt = it / 33; cj = it - mt * 33; }
        const int ct = cj < 32 ? cj : 48;
        const bool sample = mt >= 136;
        const int b = mt / 17, ti = mt - b * 17;
        auto tok_of_row = [&](int r) -> int {
            if (sample) return NPROMPT_TOK + (mt - 136) * 128 + r;
            int t = 125 * ti - 3 + r; return (t >= 0 && t < LP) ? b * LP + t : -1; };
        const bf16_t* ap[2]; const bf16_t* bp[2];
#pragma unroll
        for (int i = 0; i < 2; ++i) {
            int Rr, Cc; dma4_rc(tid, i, Rr, Cc);
            const int g = tok_of_row(Rr);
            const bf16_t* xr = g < 0 ? (const bf16_t*)(p.ws + OFF_ZROW) : (g < 16384 ? (const bf16_t*)(p.out + O_SS) + (size_t)g * 1024 : (const bf16_t*)(p.ws + OFF_XNB) + (size_t)(g - 16384) * 1024);
            ap[i] = xr + Cc; bp[i] = WIN + (size_t)(ct * 128 + Rr) * 1024 + Cc;
        }
        f32x4 acc[4][4];
        ACC_ZERO(acc);
        gemm_core_dma4(ap, bp, 32, lds, acc, tid);
#pragma unroll
        for (int m = 0; m < 4; ++m) {
            const int g = tok_of_row(wr * 64 + m * 16 + fr);
            const float rs = g >= 0 ? RS0[g] : 0.f;
#pragma unroll
            for (int n = 0; n < 4; ++n) acc[m][n] *= rs;
        }
        if (ct < 20) {
            __syncthreads();
#pragma unroll
            for (int m = 0; m < 4; ++m)
#pragma unroll
                for (int n = 0; n < 4; ++n)
#pragma unroll
                    for (int j = 0; j < 4; ++j) ctl[(wr * 64 + m * 16 + fr) * 129 + wc * 64 + n * 16 + fq * 4 + j] = acc[m][n][j];
            __syncthreads();
            const bool gdn = ct < 12; const int cc0 = gdn ? ct * 128 : (ct - 12) * 128; const int CD = gdn ? 1536 : 1024;
            if (!sample && ti == 16) {
                float* dst = p.out + (gdn ? O_PCONV : O_PMCONV) + (size_t)b * 3 * CD;
                for (int idx = tid; idx < 384; idx += 256) { int rr = idx >> 7, c = idx & 127; dst[rr * CD + cc0 + c] = ctl[(64 + rr) * 129 + c]; }
            }
            if (sample) {
                float* dst = p.out + (gdn ? O_SCONV : O_SMCONV);
                for (int idx = tid; idx < 16 * 384; idx += 256) {
                    int s = idx / 384, rem = idx - s * 384, rr = rem >> 7, c = rem & 127, bs = (mt - 136) * 16 + s;
                    dst[((size_t)bs * 3 + rr) * CD + cc0 + c] = ctl[(s * 8 + 5 + rr) * 129 + c];
                }
            }
            {
                const int c = tid & 127, half = tid >> 7;
                const float* cw = gdn ? p.in[11] : p.in[15];
                const float w0 = cw[0 * CD + cc0 + c], w1 = cw[1 * CD + cc0 + c], w2 = cw[2 * CD + cc0 + c], w3 = cw[3 * CD + cc0 + c];
                if (!sample) {
                    const int r0 = half ? 64 : 3, r1 = half ? 128 : 64;
                    float x3 = ctl[(r0 - 3) * 129 + c], x2 = ctl[(r0 - 2) * 129 + c], x1 = ctl[(r0 - 1) * 129 + c];
                    __syncthreads();
                    for (int r = r0; r < r1; ++r) {
                        float x0 = ctl[r * 129 + c];
                        float y = w0 * x3 + w1 * x2 + w2 * x1 + w3 * x0;
                        ctl[r * 129 + c] = siluf_(y);
                        x3 = x2; x2 = x1; x1 = x0;
                    }
                } else {
                    const float* st = gdn ? p.in[3] : p.in[7];
                    __syncthreads();
                    for (int s = half * 8; s < half * 8 + 8; ++s) {
                        const int bs = (mt - 136) * 16 + s;
                        float x3 = st[((size_t)bs * 3 + 0) * CD + cc0 + c], x2 = st[((size_t)bs * 3 + 1) * CD + cc0 + c], x1 = st[((size_t)bs * 3 + 2) * CD + cc0 + c];
                        for (int q = 0; q < 8; ++q) {
                            const int r = s * 8 + q;
                            float x0 = ctl[r * 129 + c];
                            float y = w0 * x3 + w1 * x2 + w2 * x1 + w3 * x0;
                            ctl[r * 129 + c] = siluf_(y);
                            x3 = x2; x2 = x1; x1 = x0;
                        }
                    }
                }
            }
            __syncthreads();
            const int row = tid & 127, hf = tid >> 7;
            float rs = 1.f;
            if (ct < 8) {
                float s = 0.f;
                for (int i = 0; i < 64; ++i) { float v = ctl[row * 129 + hf * 64 + i]; s += v * v; }
                ssq[hf * 128 + row] = s;
                __syncthreads();
                rs = rsqrtf(ssq[row] + ssq[128 + row] + 1e-6f);
                if (ct < 4) rs *= 0.08838834764831845f;
            } else if (ct >= 16) rs = 0.08838834764831845f;
            const int g = tok_of_row(row);
            const bool valid = sample || (row >= 3 && g >= 0);
            if (valid) {
                bf16_t* dst = (gdn ? QKVG + (size_t)g * 1536 : QKM + (size_t)g * 1024) + cc0 + hf * 64;
                for (int i = 0; i < 64; i += 8) {
                    float v[8];
#pragma unroll
                    for (int q = 0; q < 8; ++q) v[q] = ctl[row * 129 + hf * 64 + i + q] * rs;
                    u32x4 o; o[0] = cvtpk(v[0], v[1]); o[1] = cvtpk(v[2], v[3]); o[2] = cvtpk(v[4], v[5]); o[3] = cvtpk(v[6], v[7]);
                    *(u32x4*)(dst + i) = o;
                }
            }
            __syncthreads();
        } else if (ct < 48) {
            const int mode = ct < 24 ? 0 : (ct < 28 ? 1 : 2);
#pragma unroll
            for (int m = 0; m < 4; ++m) {
                const int row = wr * 64 + m * 16 + fr; const int g = tok_of_row(row);
                const bool valid = sample || (row >= 3 && g >= 0);
                if (!valid) continue;
                bf16_t* dst = REST + (size_t)g * RESTW + (ct - 20) * 128 + wc * 64 + fq * 4;
#pragma unroll
                for (int n = 0; n < 4; ++n) {
                    f32x4 v = acc[m][n];
                    if (mode == 1) { for (int j = 0; j < 4; ++j) v[j] = siluf_(v[j]); }
                    else if (mode == 2) { for (int j = 0; j < 4; ++j) v[j] = sigmoidf_(v[j]); }
                    u32x2 o; o[0] = cvtpk(v[0], v[1]); o[1] = cvtpk(v[2], v[3]);
                    *(u32x2*)(dst + n * 16) = o;
                }
            }
        } else {
            if (wc == 0) {
#pragma unroll
                for (int m = 0; m < 4; ++m) {
                    const int row = wr * 64 + m * 16 + fr; const int g = tok_of_row(row);
                    const bool valid = sample || (row >= 3 && g >= 0);
                    if (!valid) continue;
                    f32x4 v = acc[m][0], o;
#pragma unroll
                    for (int j = 0; j < 4; ++j) {
                        float x = v[j], r;
                        if (fq == 0) r = __expf(-__expf(p.in[12][j]) * softplusf_(x + p.in[13][j]));
                        else if (fq == 1) r = sigmoidf_(x);
                        else if (fq == 2) r = x + p.in[16][j];
                        else { float z = x + p.in[17][j]; r = -softplusf_(-z); }
                        o[j] = r;
                    }
                    *(f32x4*)(GATES + (size_t)g * 16 + fq * 4) = o;
                }
            }
        }
    }
}

__device__ __forceinline__ float row8_sum(float x) { x += dppf<0x141>(x); x += dppf<0x4E>(x); x += dppf<0xB1>(x); return x; }

template <int MIX>
__device__ void scan_unit(const Params& p, LAS unsigned char* lds, int tid, int b, int h, int rg, bool sample) {
    const int T = sample ? 8 : LP;
    const size_t g0 = sample ? (size_t)NPROMPT_TOK + b * 8 : (size_t)b * LP;
    const int wave = tid >> 6, lane = tid & 63, rr = lane >> 3, kq = lane & 7;
    const int row32 = wave * 8 + rr, row = rg * 32 + row32;
    const bf16_t* QKVG = (const bf16_t*)(p.ws + OFF_QKVG);
    const bf16_t* QKM = (const bf16_t*)(p.ws + OFF_QKM);
    const bf16_t* REST = (const bf16_t*)(p.ws + OFF_REST);
    const float* GATES = (const float*)(p.ws + OFF_GATES);
    bf16_t* oraw = (bf16_t*)(p.ws + OFF_ORAW);
    f32x2 S[8], nv[8]; float mrun = 0.f;
#pragma unroll
    for (int i = 0; i < 8; ++i) { S[i] = f32x2{0.f, 0.f}; nv[i] = f32x2{0.f, 0.f}; }
    if (sample) {
        const float* s0 = (MIX == 0 ? p.in[2] : p.in[4]) + ((size_t)(b * 4 + h) * 128 + row) * 128 + kq * 16;
#pragma unroll
        for (int c = 0; c < 4; ++c) { const f32x4 a = *(const f32x4*)(s0 + c * 4); S[c * 2] = f32x2{a[0], a[1]}; S[c * 2 + 1] = f32x2{a[2], a[3]}; }
        if (MIX == 1) {
            const float* n0 = p.in[5] + (size_t)(b * 4 + h) * 128 + kq * 16;
#pragma unroll
            for (int c = 0; c < 4; ++c) { const f32x4 a = *(const f32x4*)(n0 + c * 4); nv[c * 2] = f32x2{a[0], a[1]}; nv[c * 2 + 1] = f32x2{a[2], a[3]}; }
            mrun = p.in[6][b * 4 + h];
        }
    }
    LAS float* kbuf = (LAS float*)lds;
    LAS float* qbuf = (LAS float*)(lds + 16384);
    LAS float* vbuf = (LAS float*)(lds + 32768);
    LAS float* g1 = (LAS float*)(lds + 36864);
    LAS float* g2 = (LAS float*)(lds + 36992);
    LAS float* obuf = (LAS float*)(lds + 37120);
    __syncthreads();
    for (int t0 = 0; t0 < T; t0 += 32) {
        const int nt = min(32, T - t0);
        {
            const int tt = tid >> 3, part = tid & 7;
            if (tt < nt) {
                const size_t g = g0 + t0 + tt;
                const bf16_t* qs; const bf16_t* ks;
                if (MIX == 0) { qs = QKVG + g * 1536 + h * 128 + part * 16; ks = qs + 512; }
                else { qs = QKM + g * 1024 + h * 128 + part * 16; ks = qs + 512; }
                u32x4 k0 = *(const u32x4*)ks, k1 = *(const u32x4*)(ks + 8), q0 = *(const u32x4*)qs, q1 = *(const u32x4*)(qs + 8);
                LAS f32x4* kd = (LAS f32x4*)(kbuf + tt * 128 + part * 16);
                LAS f32x4* qd = (LAS f32x4*)(qbuf + tt * 128 + part * 16);
                kd[0] = f32x4{bflo(k0[0]), bfhi(k0[0]), bflo(k0[1]), bfhi(k0[1])}; kd[1] = f32x4{bflo(k0[2]), bfhi(k0[2]), bflo(k0[3]), bfhi(k0[3])};
                kd[2] = f32x4{bflo(k1[0]), bfhi(k1[0]), bflo(k1[1]), bfhi(k1[1])}; kd[3] = f32x4{bflo(k1[2]), bfhi(k1[2]), bflo(k1[3]), bfhi(k1[3])};
                qd[0] = f32x4{bflo(q0[0]), bfhi(q0[0]), bflo(q0[1]), bfhi(q0[1])}; qd[1] = f32x4{bflo(q0[2]), bfhi(q0[2]), bflo(q0[3]), bfhi(q0[3])};
                qd[2] = f32x4{bflo(q1[0]), bfhi(q1[0]), bflo(q1[1]), bfhi(q1[1])}; qd[3] = f32x4{bflo(q1[2]), bfhi(q1[2]), bflo(q1[3]), bfhi(q1[3])};
            }
            if (tid < 128) {
                const int t2 = tid >> 2, hv = tid & 3;
                if (t2 < nt) {
                    const size_t g = g0 + t0 + t2;
                    const bf16_t* vs = (MIX == 0 ? QKVG + g * 1536 + 1024 : REST + g * RESTW) + h * 128 + rg * 32 + hv * 8;
                    u32x4 v0 = *(const u32x4*)vs;
                    LAS f32x4* vd = (LAS f32x4*)(vbuf + t2 * 32 + hv * 8);
                    vd[0] = f32x4{bflo(v0[0]), bfhi(v0[0]), bflo(v0[1]), bfhi(v0[1])}; vd[1] = f32x4{bflo(v0[2]), bfhi(v0[2]), bflo(v0[3]), bfhi(v0[3])};
                }
            } else if (tid < 160) {
                const int t2 = tid - 128;
                if (t2 < nt) { const size_t g = g0 + t0 + t2; g1[t2] = GATES[g * 16 + (MIX ? 8 : 0) + h]; g2[t2] = GATES[g * 16 + (MIX ? 12 : 4) + h]; }
            }
        }
        __syncthreads();
#pragma unroll 2
        for (int tt = 0; tt < nt; ++tt) {
            f32x2 k2[8], q2[8];
#pragma unroll
            for (int c = 0; c < 4; ++c) {
                const f32x4 ka = *(const LAS f32x4*)(kbuf + tt * 128 + kq * 16 + c * 4), qa = *(const LAS f32x4*)(qbuf + tt * 128 + kq * 16 + c * 4);
                k2[c * 2] = f32x2{ka[0], ka[1]}; k2[c * 2 + 1] = f32x2{ka[2], ka[3]};
                q2[c * 2] = f32x2{qa[0], qa[1]}; q2[c * 2 + 1] = f32x2{qa[2], qa[3]};
            }
            const float vt = vbuf[tt * 32 + row32];
            const float ga = g1[tt], gb = g2[tt];
            float o;
            if (MIX == 0) {
                f32x2 pr = S[0] * k2[0], pr2 = S[1] * k2[1];
#pragma unroll
                for (int i = 2; i < 8; i += 2) { pr = S[i] * k2[i] + pr; pr2 = S[i + 1] * k2[i + 1] + pr2; }
                pr = pr + pr2;
                const float r = row8_sum(pr[0] + pr[1]);
                const float coef = gb * (vt - ga * r);
                const f32x2 c2 = f32x2{coef, coef}, a2 = f32x2{ga, ga};
#pragma unroll
                for (int i = 0; i < 8; ++i) S[i] = a2 * S[i] + c2 * k2[i];
                f32x2 po = S[0] * q2[0], po2 = S[1] * q2[1];
#pragma unroll
                for (int i = 2; i < 8; i += 2) { po = S[i] * q2[i] + po; po2 = S[i + 1] * q2[i + 1] + po2; }
                po = po + po2;
                o = row8_sum(po[0] + po[1]);
            } else {
                const float mn = fmaxf(gb + mrun, ga);
                const float fd = __expf(gb + mrun - mn), iw = __expf(ga - mn);
                mrun = mn;
                const float iv = iw * vt;
                const f32x2 f2 = f32x2{fd, fd}, i2 = f32x2{iv, iv}, w2 = f32x2{iw, iw};
#pragma unroll
                for (int i = 0; i < 8; ++i) { S[i] = f2 * S[i] + i2 * k2[i]; nv[i] = f2 * nv[i] + w2 * k2[i]; }
                f32x2 pn = S[0] * q2[0], pd = nv[0] * q2[0];
#pragma unroll
                for (int i = 1; i < 8; ++i) { pn = S[i] * q2[i] + pn; pd = nv[i] * q2[i] + pd; }
                const float num = row8_sum(pn[0] + pn[1]), den = row8_sum(pd[0] + pd[1]);
                o = num * __builtin_amdgcn_rcpf(fmaxf(fabsf(den), __expf(-mn)));
            }
            obuf[tt * 32 + row32] = o;
        }
        __syncthreads();
        {
            const int tt = tid >> 3, part = tid & 7;
            if (tt < nt) {
                const int t = t0 + tt;
                if (sample || t >= 16) {
                    const size_t yrow = sample ? (size_t)16384 + b * 8 + t : (size_t)b * 2048 + (t - 16);
                    const f32x4 ov = *(const LAS f32x4*)(obuf + tt * 32 + part * 4);
                    u32x2 ow; ow[0] = cvtpk(ov[0], ov[1]); ow[1] = cvtpk(ov[2], ov[3]);
                    *(u32x2*)(oraw + yrow * 1024 + MIX * 512 + h * 128 + rg * 32 + part * 4) = ow;
                }
            }
        }
    }
    {
        float* sd = p.out + (sample ? (MIX == 0 ? O_SS : O_SC) : (MIX == 0 ? O_PS : O_PC)) + ((size_t)(b * 4 + h) * 128 + row) * 128 + kq * 16;
#pragma unroll
        for (int c = 0; c < 4; ++c) *(f32x4*)(sd + c * 4) = f32x4{S[c * 2][0], S[c * 2][1], S[c * 2 + 1][0], S[c * 2 + 1][1]};
        if (MIX == 1 && rg == 0 && wave == 0 && rr == 0) {
            float* nd = p.out + (sample ? O_SN : O_PN) + (size_t)(b * 4 + h) * 128 + kq * 16;
#pragma unroll
            for (int c = 0; c < 4; ++c) *(f32x4*)(nd + c * 4) = f32x4{nv[c * 2][0], nv[c * 2][1], nv[c * 2 + 1][0], nv[c * 2 + 1][1]};
            if (kq == 0) p.out[(sample ? O_SM : O_PM) + b * 4 + h] = mrun;
        }
    }
    __syncthreads();
}

__device__ void phase2(const Params& p, LAS unsigned char* lds, int tid) {
    auto run_prompt = [&](int u) {
        const int mix = u >> 7, v = u & 127, b = v >> 4, h = (v >> 2) & 3, rg = v & 3;
        if (mix == 0) scan_unit<0>(p, lds, tid, b, h, rg, false); else scan_unit<1>(p, lds, tid, b, h, rg, false);
    };
    auto run_sample = [&](int w) {
        const int mix = w >> 11, v = w & 2047, b = v >> 4, h = (v >> 2) & 3, rg = v & 3;
        if (mix == 0) scan_unit<0>(p, lds, tid, b, h, rg, true); else scan_unit<1>(p, lds, tid, b, h, rg, true);
    };
    if (gridDim.x >= 512) {
        if (blockIdx.x < 256) run_prompt(blockIdx.x);
        else if (blockIdx.x < 384) {
            for (int w = blockIdx.x - 256; w < 4096; w += 128) run_sample(w);
        }
    } else {
        for (int u = blockIdx.x; u < 256 + 4096; u += gridDim.x) { if (u < 256) run_prompt(u); else run_sample(u - 256); }
    }
}

__device__ void phase3(const Params& p, int tid) {
    const int lane = tid & 63, gw = blockIdx.x * 4 + (tid >> 6), nw = gridDim.x * 4;
    const bf16_t* ORAW = (const bf16_t*)(p.ws + OFF_ORAW);
    float* RSH = (float*)(p.ws + OFF_RSTDH);
    for (int yrow = gw; yrow < NY; yrow += nw) {
#pragma unroll
        for (int j = 0; j < 4; ++j) {
            const u32x2 w = *(const u32x2*)(ORAW + (size_t)yrow * 1024 + j * 256 + lane * 4);
            const float a0 = bflo(w[0]), a1 = bfhi(w[0]), a2 = bflo(w[1]), a3 = bfhi(w[1]);
            float ss = a0 * a0 + a1 * a1 + a2 * a2 + a3 * a3;
            ss = half32_sum(ss);
            if ((lane & 31) == 0) RSH[(size_t)yrow * 8 + (j >> 1) * 4 + (j & 1) * 2 + (lane >> 5)] = rsqrtf(ss * (1.f / 128.f) + 1e-6f);
        }
    }
}

__device__ void phase4(const Params& p, LAS unsigned char* lds, int tid) {
    const bf16_t* ORAW = (const bf16_t*)(p.ws + OFF_ORAW);
    const bf16_t* WB = (const bf16_t*)(p.ws + OFF_WB);
    const bf16_t* WIN = (const bf16_t*)(p.ws + OFF_WIN);
    const bf16_t* REST = (const bf16_t*)(p.ws + OFF_REST);
    const float* RS0 = (const float*)(p.ws + OFF_RSTD0);
    const float* RSH = (const float*)(p.ws + OFF_RSTDH);
    bf16_t* MERGED = (bf16_t*)(p.ws + OFF_MERGED);
    const int wid = tid >> 6, lane = tid & 63, wr = wid >> 1, wc = wid & 1, fr = lane & 15, fq = lane >> 4;
    int R[4], C[4];
#pragma unroll
    for (int i = 0; i < 4; ++i) stage_rc(tid * 16 + i * 4096, R[i], C[i]);
    const bool xmap = (gridDim.x & 7) == 0;
    const int xg = blockIdx.x & 7, xs = blockIdx.x >> 3, xn = gridDim.x >> 3;
    for (int it = xmap ? xs : blockIdx.x; it < (xmap ? 272 : 136 * 16); it += (xmap ? xn : gridDim.x)) {
        const int mt = xmap ? (it >> 1) : (it >> 4), ct = xmap ? (xg + 8 * (it & 1)) : (it & 15);
        ASrc ax, ao; const bf16_t* bp[4];
        f32x4 acc[4][2];
        u32x2 pg2[2][4][2];
        LAS u32x4* pal = (LAS u32x4*)(lds + 65536 + tid * 16);
        ax.b0 = (const char*)(mt < 128 ? p.in[0] : p.in[1]);
#pragma unroll
        for (int i = 0; i < 4; ++i) ax.o0[i] = (unsigned)(((mt < 128 ? mt : mt - 128) * 128 + R[i]) * 1024 + C[i]) * 4u;
        ao.b0 = (const char*)ORAW; ao.b1 = (const char*)REST; ao.b2 = (const char*)RSH;
        {
            f32x4 accg[4][4];
#pragma unroll
            for (int i = 0; i < 4; ++i) {
                const int r = R[i], wcg = r >> 6, w = r & 63, gsel = w >> 5, col = wcg * 32 + (w & 31);
                bp[i] = WIN + (size_t)(4096 + gsel * 1024 + ct * 64 + col) * 1024 + C[i];
            }
            ACC_ZERO(accg);
            gemm_core2<3, 4>(ax, bp, 16, lds, accg, tid);
#pragma unroll
            for (int m = 0; m < 4; ++m) {
                const float r0 = RS0[yrow_to_tok(mt * 128 + wr * 64 + m * 16 + fr)];
#pragma unroll
                for (int n = 0; n < 4; ++n) {
                    const f32x4 v = accg[m][n];
                    pg2[n >> 1][m][n & 1][0] = cvtpk(sigmoidf_(v[0] * r0), sigmoidf_(v[1] * r0));
                    pg2[n >> 1][m][n & 1][1] = cvtpk(sigmoidf_(v[2] * r0), sigmoidf_(v[3] * r0));
                }
            }
        }
#pragma unroll
        for (int pass = 0; pass < 2; ++pass) {
#pragma unroll
            for (int i = 0; i < 4; ++i) {
                const int yr = mt * 128 + R[i]; const int g = yrow_to_tok(yr);
                ao.o0[i] = (unsigned)(yr * 1024 + pass * 512 + C[i]) * 2u;
                ao.o1[i] = (unsigned)(g * RESTW + 512 + pass * 512 + C[i]) * 2u;
                ao.o2[i] = (unsigned)(yr * 8 + pass * 4) * 4u;
                bp[i] = WB + (size_t)(ct * 64 + (R[i] & 63)) * 1024 + pass * 512 + C[i];
            }
            ACC_ZERO2(acc);
            gemm_core2<4, 2>(ao, bp, 8, lds, acc, tid);
            if (pass == 0) {
#pragma unroll
                for (int m = 0; m < 4; ++m) {
                    u32x4 w;
#pragma unroll
                    for (int n = 0; n < 2; ++n) {
                        const f32x4 v = acc[m][n];
                        w[n * 2] = cvtpk(v[0] * bflo(pg2[pass][m][n][0]), v[1] * bfhi(pg2[pass][m][n][0]));
                        w[n * 2 + 1] = cvtpk(v[2] * bflo(pg2[pass][m][n][1]), v[3] * bfhi(pg2[pass][m][n][1]));
                    }
                    pal[m * 256] = w;
                }
            } else {
#pragma unroll
                for (int m = 0; m < 4; ++m) {
                    const int yrow = mt * 128 + wr * 64 + m * 16 + fr;
                    bf16_t* dst = MERGED + (size_t)yrow * 1024 + ct * 64 + wc * 32 + fq * 4;
                    const u32x4 w = pal[m * 256];
#pragma unroll
                    for (int n = 0; n < 2; ++n) {
                        const f32x4 v = acc[m][n];
                        u32x2 o;
                        o[0] = cvtpk(bflo(w[n * 2]) + v[0] * bflo(pg2[pass][m][n][0]), bfhi(w[n * 2]) + v[1] * bfhi(pg2[pass][m][n][0]));
                        o[1] = cvtpk(bflo(w[n * 2 + 1]) + v[2] * bflo(pg2[pass][m][n][1]), bfhi(w[n * 2 + 1]) + v[3] * bfhi(pg2[pass][m][n][1]));
                        *(u32x2*)(dst + n * 16) = o;
                    }
                }
            }
        }
    }
}

__device__ void phase5(const Params& p, LAS unsigned char* lds, int tid) {
    const bf16_t* MERGED = (const bf16_t*)(p.ws + OFF_MERGED);
    const bf16_t* WO = (const bf16_t*)(p.ws + OFF_WO);
    float* H2 = p.out + O_Y;
    const int wid = tid >> 6, lane = tid & 63, wr = wid >> 1, wc = wid & 1, fr = lane & 15, fq = lane >> 4;
    int R[4], C[4];
#pragma unroll
    for (int i = 0; i < 4; ++i) stage_rc(tid * 16 + i * 4096, R[i], C[i]);
    for (int tile = blockIdx.x; tile < 136 * 8; tile += gridDim.x) {
        const int mt = tile >> 3, ct = tile & 7;
        const bf16_t* ap[2]; const bf16_t* bp[2];
#pragma unroll
        for (int i = 0; i < 2; ++i) { int Rr, Cc; dma4_rc(tid, i, Rr, Cc); ap[i] = MERGED + (size_t)(mt * 128 + Rr) * 1024 + Cc; bp[i] = WO + (size_t)(ct * 128 + Rr) * 1024 + Cc; }
        f32x4 acc[4][4];
        ACC_ZERO(acc);
        gemm_core_dma4(ap, bp, 32, lds, acc, tid);
#pragma unroll
        for (int m = 0; m < 4; ++m) {
            const int yrow = mt * 128 + wr * 64 + m * 16 + fr;
            const float* hs = yrow_xrow(p, yrow) + ct * 128 + wc * 64 + fq * 4;
            float* dst = H2 + (size_t)yrow * 1024 + ct * 128 + wc * 64 + fq * 4;
#pragma unroll
            for (int n = 0; n < 4; ++n) {
                f32x4 hv = *(const f32x4*)(hs + n * 16);
                f32x4 v = acc[m][n];
                *(f32x4*)(dst + n * 16) = f32x4{hv[0] + v[0], hv[1] + v[1], hv[2] + v[2], hv[3] + v[3]};
            }
        }
    }
}

__device__ void phase5b(const Params& p, int tid) {
    const int lane = tid & 63, gw = blockIdx.x * 4 + (tid >> 6), nw = gridDim.x * 4;
    const float* H2 = p.out + O_Y;
    float* RS2 = (float*)(p.ws + OFF_RSTD2);
    for (int yrow = gw; yrow < NY; yrow += nw) {
        const float* src = H2 + (size_t)yrow * 1024;
        float ss = 0.f;
#pragma unroll
        for (int j = 0; j < 4; ++j) { f32x4 v = *(const f32x4*)(src + j * 256 + lane * 4); ss += v[0] * v[0] + v[1] * v[1] + v[2] * v[2] + v[3] * v[3]; }
        ss = wave_sum(ss);
        if (lane == 0) RS2[yrow] = rsqrtf(ss * (1.f / 1024.f) + 1e-6f);
    }
}

__device__ __forceinline__ void topk16_of_128(float a, float bq, int lane, float& outv, int& outi) {
    unsigned ka = __float_as_uint(a), kb = __float_as_uint(bq);
    ka ^= (ka & 0x80000000u) ? 0xffffffffu : 0x80000000u;
    kb ^= (kb & 0x80000000u) ? 0xffffffffu : 0x80000000u;
    ka = (ka & ~127u) | (unsigned)(127 - lane);
    kb = (kb & ~127u) | (unsigned)(63 - lane);
    unsigned T = 0u;
#pragma unroll 4
    for (int bit = 31; bit >= 0; --bit) {
        const unsigned cand = T | (1u << bit);
        const int cnt = __builtin_popcountll(__ballot(ka >= cand)) + __builtin_popcountll(__ballot(kb >= cand));
        if (cnt >= 16) T = cand;
    }
    unsigned long long ma = __ballot(ka >= T), mb = __ballot(kb >= T);
    unsigned mykey = 0u;
#pragma nounroll
    for (int i = 0; i < 16; ++i) {
        unsigned kj;
        if (ma != 0ull) { const int L = __builtin_ctzll(ma); ma &= ma - 1ull; kj = (unsigned)__builtin_amdgcn_readlane((int)ka, L); }
        else { const int L = __builtin_ctzll(mb); mb &= mb - 1ull; kj = (unsigned)__builtin_amdgcn_readlane((int)kb, L); }
        if (lane == i) mykey = kj;
    }
    int rk = 0;
#pragma unroll
    for (int j = 0; j < 16; ++j) { const unsigned kj = (unsigned)__builtin_amdgcn_readlane((int)mykey, j); rk += (kj > mykey) ? 1 : 0; }
    const int dstl = lane < 16 ? rk : lane;
    const unsigned sk = (unsigned)__builtin_amdgcn_ds_permute(dstl * 4, (int)mykey);
    const unsigned fb = (sk & 0x80000000u) ? (sk ^ 0x80000000u) : ~sk;
    outv = __uint_as_float(fb);
    outi = 127 - (int)(sk & 127u);
}

__device__ void phase6(const Params& p, LAS unsigned char* lds, int tid) {
    const float* H2 = p.out + O_Y;
    const bf16_t* WQ = (const bf16_t*)(p.ws + OFF_WQ);
    const bf16_t* KEYSB = (const bf16_t*)(p.ws + OFF_KEYS);
    const float* RS2 = (const float*)(p.ws + OFF_RSTD2);
    bf16_t* SVB = (bf16_t*)(p.ws + OFF_SVB);
    unsigned char* SIB = (unsigned char*)(p.ws + OFF_SIB);
    const int wid = tid >> 6, lane = tid & 63, wr = wid >> 1, wc = wid & 1, fr = lane & 15, fq = lane >> 4;
    int R[4], C[4];
#pragma unroll
    for (int i = 0; i < 4; ++i) stage_rc(tid * 16 + i * 4096, R[i], C[i]);
    const bool xmap = (gridDim.x & 7) == 0;
    const int xg = blockIdx.x & 7, xs = blockIdx.x >> 3, xn = gridDim.x >> 3;
    for (int it = xmap ? xs : blockIdx.x; it < (xmap ? 272 : 136 * 16); it += (xmap ? xn : gridDim.x)) {
        const int mt = xmap ? (it >> 1) : (it >> 4), hp = xmap ? (xg + 8 * (it & 1)) : (it & 15);
        ASrc as; const bf16_t* bp[4];
#pragma unroll
        for (int i = 0; i < 4; ++i) { as.a[i] = H2 + (size_t)(mt * 128 + R[i]) * 1024 + C[i]; bp[i] = WQ + (size_t)(hp * 128 + R[i]) * 1024 + C[i]; }
        f32x4 acc[4][4];
        ACC_ZERO(acc);
        gemm_core2<1>(as, bp, 16, lds, acc, tid);
        __syncthreads();
#pragma unroll
        for (int m = 0; m < 4; ++m) {
            const int r = wr * 64 + m * 16 + fr;
            const float rs = RS2[mt * 128 + r];
#pragma unroll
            for (int n = 0; n < 4; ++n) {
                const f32x4 v = acc[m][n];
                u32x2 o; o[0] = cvtpk(v[0] * rs, v[1] * rs); o[1] = cvtpk(v[2] * rs, v[3] * rs);
                *(LAS u32x2*)(lds + wc * 32768 + lds_byte(r, n * 16 + fq * 4)) = o;
            }
        }
#pragma unroll
        for (int t = 0; t < 2; ++t)
#pragma unroll
            for (int i = 0; i < 4; ++i)
                __builtin_amdgcn_global_load_lds((const unsigned*)(KEYSB + (size_t)(hp * 128 + R[i]) * 128 + C[i] + t * 64), (LAS unsigned*)(lds + t * 32768 + 16384 + tid * 16 + i * 4096), 16, 0, 0);
        asm volatile("s_waitcnt vmcnt(0)" ::: "memory");
        __syncthreads();
        ACC_ZERO(acc);
        {
            int aoff[2], boff[2];
#pragma unroll
            for (int k = 0; k < 2; ++k) { aoff[k] = lds_byte(wr * 64 + fr, k * 32 + fq * 8); boff[k] = lds_byte(wc * 64 + fr, k * 32 + fq * 8); }
#pragma unroll
            for (int t = 0; t < 2; ++t) {
                LAS unsigned char* sa = lds + t * 32768;
                LAS unsigned char* sb = sa + 16384;
#pragma unroll
                for (int k = 0; k < 2; ++k) {
                    bf16x8 af[4], bfr[4];
#pragma unroll
                    for (int m = 0; m < 4; ++m) af[m] = *(const LAS bf16x8*)(sa + aoff[k] + m * 2048);
#pragma unroll
                    for (int n = 0; n < 4; ++n) bfr[n] = *(const LAS bf16x8*)(sb + boff[k] + n * 2048);
#pragma unroll
                    for (int m = 0; m < 4; ++m)
#pragma unroll
                        for (int n = 0; n < 4; ++n) acc[m][n] = __builtin_amdgcn_mfma_f32_16x16x32_bf16(bfr[n], af[m], acc[m][n], 0, 0, 0);
                }
            }
        }
        __syncthreads();
        LAS float* sct = (LAS float*)lds;
#pragma unroll
        for (int m = 0; m < 4; ++m)
#pragma unroll
            for (int n = 0; n < 4; ++n)
#pragma unroll
                for (int j = 0; j < 4; ++j) sct[(wr * 64 + m * 16 + fr) * 129 + wc * 64 + n * 16 + fq * 4 + j] = acc[m][n][j];
        __syncthreads();
#pragma nounroll
        for (int rr = 0; rr < 32; ++rr) {
            const int row = wid * 32 + rr;
            float ov; int oi;
            topk16_of_128(sct[row * 129 + lane], sct[row * 129 + 64 + lane], lane, ov, oi);
            if (lane < 16) {
                const size_t o = ((size_t)(mt * 128 + row) * 16 + hp) * 16 + lane;
                SVB[o] = (bf16_t)(cvtpk(ov, 0.f) & 0xffffu);
                SIB[o] = (unsigned char)oi;
            }
        }
        __syncthreads();
    }
}

__device__ void phase8(const Params& p, int tid) {
    const int lane = tid & 63, gw = blockIdx.x * 4 + (tid >> 6), nw = gridDim.x * 4;
    float* Y = p.out + O_Y;
    const bf16_t* SVB = (const bf16_t*)(p.ws + OFF_SVB);
    const unsigned char* SIB = (const unsigned char*)(p.ws + OFF_SIB);
    const unsigned char* PUB = p.ws + OFF_PUB;
    const unsigned char* PVB = p.ws + OFF_PVB;
    int ci, cj;
    if (lane < 16) { ci = 0; cj = lane; } else if (lane < 24) { ci = 1; cj = lane - 16; } else if (lane < 29) { ci = 2; cj = lane - 24; } else if (lane < 33) { ci = 3; cj = lane - 29; }
    else if (lane < 36) { ci = 4; cj = lane - 33; } else if (lane < 38) { ci = 5; cj = lane - 36; } else if (lane < 40) { ci = 6; cj = lane - 38; } else if (lane < 42) { ci = 7; cj = lane - 40; }
    else if (lane < 50) { ci = lane - 34; cj = 0; } else { ci = 0; cj = 0; }
    const bool cvalid = lane < 50;
    const int cid = ci * 16 + cj;
    auto select = [&](unsigned sv01, unsigned si01, int& te, float& gate) {
        const float v0 = __uint_as_float(sv01 << 16), v1 = __uint_as_float(sv01 & 0xffff0000u);
        const int i0 = (int)(si01 & 0xffu), i1 = (int)(si01 >> 8);
        const float cv = __shfl(v0, ci) + __shfl(v1, cj);
        const int ecand = __shfl(i0, ci) * 128 + __shfl(i1, cj);
        unsigned key = __float_as_uint(cv);
        key ^= (key & 0x80000000u) ? 0xffffffffu : 0x80000000u;
        key = cvalid ? ((key & ~255u) | (unsigned)(255 - cid)) : 0u;
        int rk = 0;
#pragma unroll 10
        for (int j = 0; j < 50; ++j) { const unsigned kj = (unsigned)__builtin_amdgcn_readlane((int)key, j); rk += (kj > key) ? 1 : 0; }
        const int dstl = cvalid ? rk : lane;
        const unsigned sk = (unsigned)__builtin_amdgcn_ds_permute(dstl * 4, (int)key);
        te = __builtin_amdgcn_ds_permute(dstl * 4, ecand) & 16383;
        const unsigned fb = (sk & 0x80000000u) ? (sk ^ 0x80000000u) : ~sk;
        const float tv = __uint_as_float(fb);
        const float mx = __int_as_float(__builtin_amdgcn_readlane(__float_as_int(tv), 0));
        const float ex = lane < 16 ? __expf(tv - mx) : 0.f;
        gate = ex / wave_sum(ex);
    };
    for (int yrow = gw; yrow < NY; yrow += nw) {
        float* hrow = Y + (size_t)yrow * 1024;
        const size_t svbase = (size_t)yrow * 256 + (lane & 15);
        unsigned svn = (unsigned)SVB[svbase] | ((unsigned)SVB[svbase + 16] << 16);
        unsigned sin_ = (unsigned)SIB[svbase] | ((unsigned)SIB[svbase + 16] << 8);
        float hv[16], x[16], ya[16]; float ss = 0.f;
#pragma unroll
        for (int jj = 0; jj < 2; ++jj) {
            const f32x4 a = *(const f32x4*)(hrow + lane * 16 + jj * 8), b = *(const f32x4*)(hrow + lane * 16 + jj * 8 + 4);
#pragma unroll
            for (int k = 0; k < 4; ++k) { hv[jj * 8 + k] = a[k]; hv[jj * 8 + 4 + k] = b[k]; }
        }
#pragma unroll
        for (int i = 0; i < 16; ++i) { ss += hv[i] * hv[i]; ya[i] = 0.f; }
        ss = wave_sum(ss);
        {
            const float rstd = rsqrtf(ss * (1.f / 1024.f) + 1e-6f);
#pragma unroll
            for (int jj = 0; jj < 2; ++jj) {
                const f32x4 a = *(const f32x4*)(p.in[21] + lane * 16 + jj * 8), b = *(const f32x4*)(p.in[21] + lane * 16 + jj * 8 + 4);
#pragma unroll
                for (int k = 0; k < 4; ++k) { x[jj * 8 + k] = hv[jj * 8 + k] * rstd * a[k]; x[jj * 8 + 4 + k] = hv[jj * 8 + 4 + k] * rstd * b[k]; }
            }
        }
        int te_c; float gate_c;
        select(svn, sin_, te_c, gate_c);
        svn = (unsigned)SVB[svbase + 32] | ((unsigned)SVB[svbase + 48] << 16);
        sin_ = (unsigned)SIB[svbase + 32] | ((unsigned)SIB[svbase + 48] << 8);
#pragma nounroll
        for (int h = 0; h < 8; ++h) {
            int te_n = 0; float gate_n = 0.f;
            {
                u32x4 u0[8], u1[8], vv[8]; float wk[8];
#define LOADROWS(dst, TAB, k0) _Pragma("unroll") for (int g = 0; g < 8; ++g) { const int e = __builtin_amdgcn_readlane(te_c, (k0) + g) & 16383; dst[g] = *(const u32x4*)((TAB) + (size_t)e * 1024 + lane * 16); }
#define DOTS(src, k0) { float dd[8]; \
                    _Pragma("unroll") for (int g = 0; g < 8; ++g) { float d = 0.f; \
                        _Pragma("unroll") for (int q = 0; q < 4; ++q) { const f32x2 lo = __builtin_amdgcn_cvt_pk_f32_fp8((int)src[g][q], false), hi = __builtin_amdgcn_cvt_pk_f32_fp8((int)src[g][q], true); \
                            d += lo[0] * x[q * 4] + lo[1] * x[q * 4 + 1] + hi[0] * x[q * 4 + 2] + hi[1] * x[q * 4 + 3]; } \
                        dd[g] = d; } \
                      \
                    float e4[4], e2[2]; \
                    _Pragma("unroll") for (int j = 0; j < 4; ++j) { auto sw = __builtin_amdgcn_permlane32_swap(__float_as_uint(dd[j]), __float_as_uint(dd[j + 4]), false, false); e4[j] = __uint_as_float(sw[0]) + __uint_as_float(sw[1]); } \
                    _Pragma("unroll") for (int j = 0; j < 2; ++j) { auto sw = __builtin_amdgcn_permlane16_swap(__float_as_uint(e4[j]), __float_as_uint(e4[j + 2]), false, false); e2[j] = __uint_as_float(sw[0]) + __uint_as_float(sw[1]); } \
                    const float t0 = e2[0] + dppf<0x128>(e2[0]), t1 = e2[1] + dppf<0x128>(e2[1]); \
                    float e1 = (lane & 8) ? t1 : t0; \
                    e1 += dppf<0x141>(e1); e1 += dppf<0x4E>(e1); e1 += dppf<0xB1>(e1); \
                    const float dtot = e1 * (1.f / 256.f); \
                    const float act = 0.5f * dtot * (1.f + erff(dtot * 0.70710678118654752f)); \
                    const float wmine = __shfl(gate_c, (k0) + ((lane >> 3) & 7)) * act * (1.f / 64.f); \
                    _Pragma("unroll") for (int g = 0; g < 8; ++g) wk[g] = __int_as_float(__builtin_amdgcn_readlane(__float_as_int(wmine), ((g >> 2) & 1) * 32 + ((g >> 1) & 1) * 16 + (g & 1) * 8)); }
#define ACCUM() _Pragma("unroll") for (int g = 0; g < 8; ++g) { const float w = wk[g]; \
                    _Pragma("unroll") for (int q = 0; q < 4; ++q) { const f32x2 lo = __builtin_amdgcn_cvt_pk_f32_fp8((int)vv[g][q], false), hi = __builtin_amdgcn_cvt_pk_f32_fp8((int)vv[g][q], true); \
                        ya[q * 4] += w * lo[0]; ya[q * 4 + 1] += w * lo[1]; ya[q * 4 + 2] += w * hi[0]; ya[q * 4 + 3] += w * hi[1]; } }
                LOADROWS(u0, PUB, 0)
                if (h < 7) {
                    select(svn, sin_, te_n, gate_n);
                    if (h < 6) {
                        svn = (unsigned)SVB[svbase + (h + 2) * 32] | ((unsigned)SVB[svbase + (h + 2) * 32 + 16] << 16);
                        sin_ = (unsigned)SIB[svbase + (h + 2) * 32] | ((unsigned)SIB[svbase + (h + 2) * 32 + 16] << 8);
                    }
                }
                DOTS(u0, 0)
                LOADROWS(vv, PVB, 0)
                LOADROWS(u1, PUB, 8)
                ACCUM()
                DOTS(u1, 8)
                LOADROWS(vv, PVB, 8)
                ACCUM()
#undef LOADROWS
#undef DOTS
#undef ACCUM
            }
            te_c = te_n; gate_c = gate_n;
        }
        float s2 = 0.f;
#pragma unroll
        for (int jj = 0; jj < 2; ++jj) {
            const f32x4 a = *(const f32x4*)(hrow + lane * 16 + jj * 8), b = *(const f32x4*)(hrow + lane * 16 + jj * 8 + 4);
#pragma unroll
            for (int k = 0; k < 4; ++k) { hv[jj * 8 + k] = a[k] + ya[jj * 8 + k]; hv[jj * 8 + 4 + k] = b[k] + ya[jj * 8 + 4 + k]; }
        }
#pragma unroll
        for (int i = 0; i < 16; ++i) s2 += hv[i] * hv[i];
        s2 = wave_sum(s2);
        const float rstd2 = rsqrtf(s2 * (1.f / 1024.f) + 1e-6f);
#pragma unroll
        for (int jj = 0; jj < 2; ++jj) {
            const f32x4 a = *(const f32x4*)(p.in[26] + lane * 16 + jj * 8), b = *(const f32x4*)(p.in[26] + lane * 16 + jj * 8 + 4);
            *(f32x4*)(hrow + lane * 16 + jj * 8) = f32x4{hv[jj * 8 + 0] * rstd2 * a[0], hv[jj * 8 + 1] * rstd2 * a[1], hv[jj * 8 + 2] * rstd2 * a[2], hv[jj * 8 + 3] * rstd2 * a[3]};
            *(f32x4*)(hrow + lane * 16 + jj * 8 + 4) = f32x4{hv[jj * 8 + 4] * rstd2 * b[0], hv[jj * 8 + 5] * rstd2 * b[1], hv[jj * 8 + 6] * rstd2 * b[2], hv[jj * 8 + 7] * rstd2 * b[3]};
        }
    }
}

__device__ __forceinline__ void grid_barrier(unsigned* ctr, unsigned target) {
    asm volatile("s_waitcnt vmcnt(0)" ::: "memory");
    __syncthreads();
    if (threadIdx.x == 0) {
        __builtin_amdgcn_fence(__ATOMIC_RELEASE, "agent");
        asm volatile("s_waitcnt vmcnt(0)" ::: "memory");
        __hip_atomic_fetch_add(ctr, 1u, __ATOMIC_RELAXED, __HIP_MEMORY_SCOPE_AGENT);
        while (__hip_atomic_load(ctr, __ATOMIC_RELAXED, __HIP_MEMORY_SCOPE_AGENT) < target) __builtin_amdgcn_s_sleep(1);
        __builtin_amdgcn_fence(__ATOMIC_ACQUIRE, "agent");
        asm volatile("s_waitcnt vmcnt(0)" ::: "memory");
    }
    __syncthreads();
}
__device__ __forceinline__ void cg_sync_full(cg::grid_group& grid) {
    asm volatile("s_waitcnt vmcnt(0)" ::: "memory");
    grid.sync();
    if (threadIdx.x == 0) { __builtin_amdgcn_fence(__ATOMIC_ACQUIRE, "agent"); asm volatile("s_waitcnt vmcnt(0)" ::: "memory"); }
    __syncthreads();
}

__global__ void __launch_bounds__(256, 2) fwd_megakernel(Params p) {
    extern __shared__ __attribute__((aligned(16))) unsigned char lds_raw[];
    LAS unsigned char* lds = (LAS unsigned char*)lds_raw;
    cg::grid_group grid = cg::this_grid();
    const int tid = threadIdx.x;
    unsigned* bar = (unsigned*)(p.ws + OFF_BAR);
    const unsigned nb = gridDim.x;
    phase0(p, lds, tid);
    cg_sync_full(grid);
    phase1(p, lds, tid);
    grid_barrier(bar, nb * 1);
    phase2(p, lds, tid);
    grid_barrier(bar, nb * 2);
    phase3(p, tid);
    grid_barrier(bar, nb * 3);
    phase4(p, lds, tid);
    grid_barrier(bar, nb * 4);
    phase5(p, lds, tid);
    grid_barrier(bar, nb * 5);
    phase5b(p, tid);
    grid_barrier(bar, nb * 6);
    phase6(p, lds, tid);
    grid_barrier(bar, nb * 7);
    phase8(p, tid);
}

extern "C" void kernel_launch(void* const* d_in, const int* in_sizes, int n_in, void* d_out, int out_size, void* d_ws, size_t ws_size, hipStream_t stream) {
    static int grid_blocks = 0;
    if (!grid_blocks) {
        int dev = 0, cus = 0, per_cu = 0;
        (void)hipGetDevice(&dev);
        (void)hipDeviceGetAttribute(&cus, hipDeviceAttributeMultiprocessorCount, dev);
        (void)hipFuncSetAttribute((const void*)fwd_megakernel, hipFuncAttributeMaxDynamicSharedMemorySize, LDS_BYTES);
        (void)hipOccupancyMaxActiveBlocksPerMultiprocessor(&per_cu, (const void*)fwd_megakernel, 256, LDS_BYTES);
        if (per_cu > 2) per_cu = 2;
        if (per_cu < 1) per_cu = 1;
        grid_blocks = cus * per_cu;
        if (ws_size < WS_END) fprintf(stderr, "kernel_launch: workspace too small: %zu < %zu\n", ws_size, (size_t)WS_END);
    }
    if (ws_size < WS_END) return;
    Params p{};
    for (int i = 0; i < 27; ++i) p.in[i] = (const float*)d_in[i];
    p.out = (float*)d_out;
    p.ws = (unsigned char*)d_ws;
    (void)hipMemsetAsync((unsigned char*)d_ws + OFF_BAR, 0, 256, stream);
    void* args[] = {&p};
    hipError_t e = hipLaunchCooperativeKernel((const void*)fwd_megakernel, dim3(grid_blocks), dim3(256), args, LDS_BYTES, stream);
    if (e != hipSuccess) fprintf(stderr, "cooperative launch failed: %s (grid %d)\n", hipGetErrorString(e), grid_blocks);
}
```

```cpp
#include <hip/hip_runtime.h>
#include <hip/hip_cooperative_groups.h>
#include <cstdio>
#include <cstdint>
namespace cg = cooperative_groups;

#define LAS __attribute__((address_space(3)))
#define PROBE_MODE 0
typedef unsigned short bf16_t;
typedef short bf16x8 __attribute__((ext_vector_type(8)));
typedef float f32x4 __attribute__((ext_vector_type(4)));
typedef unsigned u32x4 __attribute__((ext_vector_type(4)));
typedef unsigned u32x2 __attribute__((ext_vector_type(2)));
typedef float f32x2 __attribute__((ext_vector_type(2)));

constexpr int D = 1024;
constexpr int NTOK = 17536;
constexpr int NPROMPT_TOK = 16512;
constexpr int LP = 2064;
constexpr int NY = 17408;
constexpr int NIN_T = 6272;
constexpr int RESTW = 1536;

constexpr size_t O_Y = 0;
constexpr size_t O_PS = 17825792;
constexpr size_t O_PCONV = O_PS + 524288;
constexpr size_t O_PC = O_PCONV + 36864;
constexpr size_t O_PN = O_PC + 524288;
constexpr size_t O_PM = O_PN + 4096;
constexpr size_t O_PMCONV = O_PM + 32;
constexpr size_t O_SS = O_PMCONV + 24576;
constexpr size_t O_SCONV = O_SS + 8388608;
constexpr size_t O_SC = O_SCONV + 589824;
constexpr size_t O_SN = O_SC + 8388608;
constexpr size_t O_SM = O_SN + 65536;
constexpr size_t O_SMCONV = O_SM + 512;

constexpr size_t OFF_WIN = 0;
constexpr size_t OFF_WB = OFF_WIN + (size_t)NIN_T * 1024 * 2;
constexpr size_t OFF_WO = OFF_WB + 2097152;
constexpr size_t OFF_WQ = OFF_WO + 2097152;
constexpr size_t OFF_KEYS = OFF_WQ + 4194304;
constexpr size_t OFF_ZROW = OFF_KEYS + 524288;
constexpr size_t OFF_RSTD0 = OFF_ZROW + 4096;
constexpr size_t OFF_RSTDH = OFF_RSTD0 + 70144;
constexpr size_t OFF_RSTD2 = OFF_RSTDH + 557056;
constexpr size_t OFF_QKVG = OFF_RSTD2 + 69632;
constexpr size_t OFF_QKM = OFF_QKVG + (size_t)NTOK * 1536 * 2;
constexpr size_t OFF_REST = OFF_QKM + (size_t)NTOK * 1024 * 2;
constexpr size_t OFF_GATES = OFF_REST + (size_t)NTOK * RESTW * 2;
constexpr size_t OFF_ORAW = OFF_GATES + (size_t)NTOK * 16 * 4;
constexpr size_t OFF_MERGED = OFF_ORAW + (size_t)NY * 1024 * 2;
constexpr size_t OFF_SVB = OFF_MERGED + (size_t)NY * 1024 * 2;
constexpr size_t OFF_SIB = OFF_SVB + (size_t)NY * 256 * 2;
constexpr size_t OFF_PUB = OFF_SIB + (size_t)NY * 256;
constexpr size_t OFF_PVB = OFF_PUB + (size_t)16384 * 1024;
constexpr size_t OFF_XNB = OFF_PVB + (size_t)16384 * 1024;
constexpr size_t OFF_BAR = OFF_XNB + (size_t)1152 * 1024 * 2;
constexpr size_t WS_END = OFF_BAR + 256;
static_assert(WS_END <= 320004672ull, "workspace plan exceeds the guaranteed size");

constexpr int LDS_BYTES = 81920;

struct Params {
    const float* in[27];
    float* out;
    unsigned char* ws;
};

__device__ __forceinline__ unsigned cvtpk(float lo, float hi) { unsigned r; asm volatile("v_cvt_pk_bf16_f32 %0, %1, %2" : "=v"(r) : "v"(lo), "v"(hi)); return r; }
typedef __bf16 bf16x2_t __attribute__((ext_vector_type(2)));
__device__ __forceinline__ float dot2bf(unsigned a, unsigned b, float c) { return __builtin_amdgcn_fdot2_f32_bf16(__builtin_bit_cast(bf16x2_t, a), __builtin_bit_cast(bf16x2_t, b), c, false); }
__device__ __forceinline__ float bflo(unsigned u) { return __uint_as_float(u << 16); }
__device__ __forceinline__ float bfhi(unsigned u) { return __uint_as_float(u & 0xffff0000u); }
template <int CTRL> __device__ __forceinline__ float dppf(float x) {
    return __builtin_bit_cast(float, __builtin_amdgcn_mov_dpp(__builtin_bit_cast(int, x), CTRL, 0xf, 0xf, true));
}
__device__ __forceinline__ float row16_sum(float x) { x += dppf<0x128>(x); x += dppf<0x124>(x); x += dppf<0x122>(x); x += dppf<0x121>(x); return x; }
__device__ __forceinline__ float row16_max(float x) { x = fmaxf(x, dppf<0x128>(x)); x = fmaxf(x, dppf<0x124>(x)); x = fmaxf(x, dppf<0x122>(x)); x = fmaxf(x, dppf<0x121>(x)); return x; }
__device__ __forceinline__ float half32_sum(float x) {
    x = row16_sum(x);
    auto s = __builtin_amdgcn_permlane16_swap(__float_as_uint(x), __float_as_uint(x), false, false);
    return __uint_as_float(s[0]) + __uint_as_float(s[1]);
}
__device__ __forceinline__ float wave_sum(float x) {
    x = half32_sum(x);
    auto t = __builtin_amdgcn_permlane32_swap(__float_as_uint(x), __float_as_uint(x), false, false);
    return __uint_as_float(t[0]) + __uint_as_float(t[1]);
}
__device__ __forceinline__ float wave_max(float x) {
    x = row16_max(x);
    auto s = __builtin_amdgcn_permlane16_swap(__float_as_uint(x), __float_as_uint(x), false, false);
    x = fmaxf(__uint_as_float(s[0]), __uint_as_float(s[1]));
    auto t = __builtin_amdgcn_permlane32_swap(__float_as_uint(x), __float_as_uint(x), false, false);
    return fmaxf(__uint_as_float(t[0]), __uint_as_float(t[1]));
}
__device__ __forceinline__ float sigmoidf_(float x) { return 1.f / (1.f + __expf(-x)); }
__device__ __forceinline__ float siluf_(float x) { return x / (1.f + __expf(-x)); }
__device__ __forceinline__ float softplusf_(float x) { return fmaxf(x, 0.f) + log1pf(__expf(-fabsf(x))); }

__device__ __forceinline__ int yrow_to_tok(int yrow) { return yrow < 16384 ? (yrow >> 11) * LP + (yrow & 2047) + 16 : NPROMPT_TOK + (yrow - 16384); }

__device__ __forceinline__ int lds_byte(int r, int c) { int st = (r >> 4) * 2 + (c >> 5), rr = r & 15, cc = c & 31, ob = rr * 64 + cc * 2; return st * 1024 + (ob ^ (((ob >> 9) & 1) << 5)); }
__device__ __forceinline__ void stage_rc(int b, int& R, int& C) { int st = b >> 10, sb = b & 1023, swz = sb ^ (((sb >> 9) & 1) << 5); R = (st >> 1) * 16 + (swz >> 6); C = (st & 1) * 32 + ((swz & 63) >> 1); }

struct ASrc { const void* a[4]; const bf16_t* g[4]; const float* rs[4]; const char* b0; const char* b1; const char* b2; unsigned o0[4], o1[4], o2[4]; };

template <int AMODE, int NT = 4>
__device__ __forceinline__ void gemm_core2(const ASrc& as, const bf16_t* const (&bp)[4], int nk, LAS unsigned char* lds, f32x4 (&acc)[4][NT], int tid) {
    const int wid = tid >> 6, lane = tid & 63, wr = wid >> 1, wc = wid & 1, fr = lane & 15, fq = lane >> 4;
    f32x4 fa[4][2]; u32x4 oa[4], ga[4]; float rsv[4];
#define ISSUE(kt, buf) do { _Pragma("unroll") for (int _i = 0; _i < 4; ++_i) { \
        if (_i < NT) __builtin_amdgcn_global_load_lds((const unsigned*)(bp[_i] + (kt) * 64), (LAS unsigned*)(lds + (buf) * 32768 + 16384 + tid * 16 + _i * 4096), 16, 0, 0); \
        if (AMODE == 0) __builtin_amdgcn_global_load_lds((const unsigned*)((const bf16_t*)as.a[_i] + (kt) * 64), (LAS unsigned*)(lds + (buf) * 32768 + tid * 16 + _i * 4096), 16, 0, 0); \
        if (AMODE == 1) { const float* _s = (const float*)as.a[_i] + (kt) * 64; fa[_i][0] = *(const f32x4*)_s; fa[_i][1] = *(const f32x4*)(_s + 4); } \
        if (AMODE == 2) { oa[_i] = *(const u32x4*)((const bf16_t*)as.a[_i] + (kt) * 64); ga[_i] = *(const u32x4*)(as.g[_i] + (kt) * 64); rsv[_i] = as.rs[_i][(kt) >> 1]; } \
        if (AMODE == 3) { const float* _s = (const float*)(as.b0 + as.o0[_i]) + (kt) * 64; fa[_i][0] = *(const f32x4*)_s; fa[_i][1] = *(const f32x4*)(_s + 4); } \
        if (AMODE == 4) { oa[_i] = *(const u32x4*)((const bf16_t*)(as.b0 + as.o0[_i]) + (kt) * 64); ga[_i] = *(const u32x4*)((const bf16_t*)(as.b1 + as.o1[_i]) + (kt) * 64); rsv[_i] = ((const float*)(as.b2 + as.o2[_i]))[(kt) >> 1]; } } } while (0)
#define WRITEA(buf) do { _Pragma("unroll") for (int _i = 0; _i < 4; ++_i) { u32x4 _w; \
        if (AMODE == 1 || AMODE == 3) { _w[0] = cvtpk(fa[_i][0][0], fa[_i][0][1]); _w[1] = cvtpk(fa[_i][0][2], fa[_i][0][3]); _w[2] = cvtpk(fa[_i][1][0], fa[_i][1][1]); _w[3] = cvtpk(fa[_i][1][2], fa[_i][1][3]); } \
        if (AMODE == 2 || AMODE == 4) { _Pragma("unroll") for (int _q = 0; _q < 4; ++_q) _w[_q] = cvtpk(bflo(oa[_i][_q]) * rsv[_i] * bflo(ga[_i][_q]), bfhi(oa[_i][_q]) * rsv[_i] * bfhi(ga[_i][_q])); } \
        *(LAS u32x4*)(lds + (buf) * 32768 + tid * 16 + _i * 4096) = _w; } } while (0)
    int aoff[2], boff[2];
#pragma unroll
    for (int k = 0; k < 2; ++k) { aoff[k] = lds_byte(wr * 64 + fr, k * 32 + fq * 8); boff[k] = lds_byte(wc * (NT * 16) + fr, k * 32 + fq * 8); }
    __syncthreads();
    ISSUE(0, 0);
    if (AMODE != 0) WRITEA(0);
    for (int t = 0; t < nk; ++t) {
        asm volatile("s_waitcnt vmcnt(0)" ::: "memory");
        __syncthreads();
        if (t + 1 < nk) ISSUE(t + 1, (t + 1) & 1);
        LAS unsigned char* sa = lds + (t & 1) * 32768;
        LAS unsigned char* sb = sa + 16384;
#pragma unroll
        for (int k = 0; k < 2; ++k) {
            bf16x8 af[4], bfr[NT];
#pragma unroll
            for (int m = 0; m < 4; ++m) af[m] = *(const LAS bf16x8*)(sa + aoff[k] + m * 2048);
#pragma unroll
            for (int n = 0; n < NT; ++n) bfr[n] = *(const LAS bf16x8*)(sb + boff[k] + n * 2048);
#pragma unroll
            for (int m = 0; m < 4; ++m)
#pragma unroll
                for (int n = 0; n < NT; ++n) acc[m][n] = __builtin_amdgcn_mfma_f32_16x16x32_bf16(bfr[n], af[m], acc[m][n], 0, 0, 0);
        }
        if (AMODE != 0 && t + 1 < nk) WRITEA((t + 1) & 1);
    }
#undef ISSUE
#undef WRITEA
}
__device__ __forceinline__ int sw4(int x) { return (0x1320 >> (4 * x)) & 3; }
__device__ __forceinline__ void dma4_rc(int tid, int i, int& R, int& C) { const int c = tid + i * 256; R = c >> 2; C = ((c & 3) ^ sw4((R >> 2) & 3)) * 8; }
__device__ __forceinline__ void gemm_core_dma4(const bf16_t* const (&ap)[2], const bf16_t* const (&bp)[2], int nk, LAS unsigned char* lds, f32x4 (&acc)[4][4], int tid) {
    const int wid = tid >> 6, lane = tid & 63, wr = wid >> 1, wc = wid & 1, fr = lane & 15, fq = lane >> 4;
    const int fsw = (fq ^ sw4((fr >> 2) & 3)) * 16;
    const int aoff = (wr * 64 + fr) * 64 + fsw, boff = (wc * 64 + fr) * 64 + fsw;
#define D4_ISSUE(kt) do { const int _st = ((kt) & 3) * 16384; _Pragma("unroll") for (int _i = 0; _i < 2; ++_i) { \
        __builtin_amdgcn_global_load_lds((const unsigned*)(ap[_i] + (kt) * 32), (LAS unsigned*)(lds + _st + tid * 16 + _i * 4096), 16, 0, 0); \
        __builtin_amdgcn_global_load_lds((const unsigned*)(bp[_i] + (kt) * 32), (LAS unsigned*)(lds + _st + 8192 + tid * 16 + _i * 4096), 16, 0, 0); } } while (0)
    asm volatile("s_waitcnt lgkmcnt(0)" ::: "memory");
    __builtin_amdgcn_s_barrier();
    D4_ISSUE(0); D4_ISSUE(1); D4_ISSUE(2);
    for (int t = 0; t < nk; ++t) {
        if (t + 2 < nk) asm volatile("s_waitcnt vmcnt(8)" ::: "memory");
        else if (t + 1 < nk) asm volatile("s_waitcnt vmcnt(4)" ::: "memory");
        else asm volatile("s_waitcnt vmcnt(0)" ::: "memory");
        asm volatile("s_waitcnt lgkmcnt(0)" ::: "memory");
        __builtin_amdgcn_s_barrier();
        asm volatile("" ::: "memory");
        if (t + 3 < nk) D4_ISSUE(t + 3);
        LAS unsigned char* sa = lds + (t & 3) * 16384;
        LAS unsigned char* sb = sa + 8192;
        bf16x8 af[4], bfr[4];
#pragma unroll
        for (int m = 0; m < 4; ++m) af[m] = *(const LAS bf16x8*)(sa + aoff + m * 1024);
#pragma unroll
        for (int n = 0; n < 4; ++n) bfr[n] = *(const LAS bf16x8*)(sb + boff + n * 1024);
#pragma unroll
        for (int m = 0; m < 4; ++m)
#pragma unroll
            for (int n = 0; n < 4; ++n) acc[m][n] = __builtin_amdgcn_mfma_f32_16x16x32_bf16(bfr[n], af[m], acc[m][n], 0, 0, 0);
    }
#undef D4_ISSUE
}
#define ACC_ZERO2(acc) do { _Pragma("unroll") for (int _m = 0; _m < 4; ++_m) _Pragma("unroll") for (int _n = 0; _n < 2; ++_n) acc[_m][_n] = f32x4{0.f, 0.f, 0.f, 0.f}; } while (0)
#define ACC_ZERO(acc) do { _Pragma("unroll") for (int _m = 0; _m < 4; ++_m) _Pragma("unroll") for (int _n = 0; _n < 4; ++_n) acc[_m][_n] = f32x4{0.f, 0.f, 0.f, 0.f}; } while (0)

__device__ __forceinline__ const float* tok_xrow(const Params& p, int g) {
    if (g < 0) return (const float*)(p.ws + OFF_ZROW);
    if (g < NPROMPT_TOK) { const int b = g / LP, t = g - b * LP; return t < 16 ? p.in[8] + t * 1024 : p.in[0] + ((size_t)b * 2048 + (t - 16)) * 1024; }
    return p.in[1] + (size_t)(g - NPROMPT_TOK) * 1024;
}
__device__ __forceinline__ const float* yrow_xrow(const Params& p, int yrow) { return yrow < 16384 ? p.in[0] + (size_t)yrow * 1024 : p.in[1] + (size_t)(yrow - 16384) * 1024; }

__device__ __forceinline__ int win_srccol(int np) {
    if (np < 1536) return np;
    if (np < 2560) return 2056 + (np - 1536);
    if (np < 3072) return 3080 + (np - 2560);
    if (np < 3584) return 1544 + (np - 3072);
    if (np < 4096) return 3600 + (np - 3584);
    if (np < 5120) return 4112 + (np - 4096);
    if (np < 6144) return 5136 + (np - 5120);
    int j = np - 6144;
    if (j < 4) return 1536 + j;
    if (j < 8) return 1540 + (j - 4);
    if (j < 12) return 3592 + (j - 8);
    if (j < 16) return 3596 + (j - 12);
    return -1;
}

__device__ void phase0(const Params& p, LAS unsigned char* lds, int tid) {
    LAS float* tile = (LAS float*)lds;
    for (int u = blockIdx.x; u < 2592; u += gridDim.x) {
        const float* src; bf16_t* dst; int N, nt, kt, wsel; bool remap = false;
        if (u < 1568) { src = p.in[10]; dst = (bf16_t*)(p.ws + OFF_WIN); N = 6160; nt = u >> 4; kt = u & 15; remap = true; wsel = 0; }
        else if (u < 1824) { int v = u - 1568; src = p.in[19]; dst = (bf16_t*)(p.ws + OFF_WB); N = 1024; nt = v >> 4; kt = v & 15; wsel = 1; }
        else if (u < 2080) { int v = u - 1824; src = p.in[20]; dst = (bf16_t*)(p.ws + OFF_WO); N = 1024; nt = v >> 4; kt = v & 15; wsel = 2; }
        else { int v = u - 2080; src = p.in[22]; dst = (bf16_t*)(p.ws + OFF_WQ); N = 2048; nt = v >> 4; kt = v & 15; wsel = 3; }
        const int c = tid & 63, r0 = tid >> 6;
        int sc = nt * 64 + c; if (remap) sc = win_srccol(sc);
        for (int r = r0; r < 64; r += 4) {
            const int k = kt * 64 + r;
            float gk = 1.f;
            if (wsel == 0) gk = p.in[9][k];
            else if (wsel == 1) gk = k < 512 ? p.in[14][k & 127] : p.in[18][k - 512];
            else if (wsel == 3) gk = p.in[21][k];
            tile[r * 65 + c] = sc >= 0 ? src[(size_t)k * N + sc] * gk : 0.f;
        }
        __syncthreads();
        const int cc2 = (tid & 31) * 2, rr0 = tid >> 5;
        for (int rr = rr0; rr < 64; rr += 8) {
            unsigned v = cvtpk(tile[cc2 * 65 + rr], tile[(cc2 + 1) * 65 + rr]);
            *(unsigned*)(dst + (size_t)(nt * 64 + rr) * 1024 + kt * 64 + cc2) = v;
        }
        __syncthreads();
    }
    {
        const float* ks = p.in[23]; bf16_t* kd = (bf16_t*)(p.ws + OFF_KEYS);
        for (int i = (blockIdx.x * 256 + tid) * 4; i < 262144; i += gridDim.x * 256 * 4) {
            f32x4 v = *(const f32x4*)(ks + i);
            u32x2 o; o[0] = cvtpk(v[0], v[1]); o[1] = cvtpk(v[2], v[3]);
            *(u32x2*)(kd + i) = o;
        }
        const size_t NE = (size_t)16384 * 1024, stride = (size_t)gridDim.x * 256 * 16;
        unsigned char* pub = p.ws + OFF_PUB; unsigned char* pvb = p.ws + OFF_PVB;
        for (size_t i = ((size_t)blockIdx.x * 256 + tid) * 16; i < NE; i += stride) {
            u32x4 ou, ov;
#pragma unroll
            for (int q = 0; q < 4; ++q) {
                const f32x4 a = *(const f32x4*)(p.in[24] + i + q * 4), c = *(const f32x4*)(p.in[25] + i + q * 4);
                int w = __builtin_amdgcn_cvt_pk_fp8_f32(fminf(fmaxf(a[0] * 256.f, -448.f), 448.f), fminf(fmaxf(a[1] * 256.f, -448.f), 448.f), 0, false);
                w = __builtin_amdgcn_cvt_pk_fp8_f32(fminf(fmaxf(a[2] * 256.f, -448.f), 448.f), fminf(fmaxf(a[3] * 256.f, -448.f), 448.f), w, true);
                ou[q] = (unsigned)w;
                int z = __builtin_amdgcn_cvt_pk_fp8_f32(fminf(fmaxf(c[0] * 64.f, -448.f), 448.f), fminf(fmaxf(c[1] * 64.f, -448.f), 448.f), 0, false);
                z = __builtin_amdgcn_cvt_pk_fp8_f32(fminf(fmaxf(c[2] * 64.f, -448.f), 448.f), fminf(fmaxf(c[3] * 64.f, -448.f), 448.f), z, true);
                ov[q] = (unsigned)z;
            }
            *(u32x4*)(pub + i) = ou;
            *(u32x4*)(pvb + i) = ov;
        }
    }
    if (blockIdx.x == 0) { float* z = (float*)(p.ws + OFF_ZROW); for (int i = tid; i < 1024; i += 256) z[i] = 0.f; }
    {
        const int lane = tid & 63, gw = blockIdx.x * 4 + (tid >> 6), nw = gridDim.x * 4;
        float* RS0 = (float*)(p.ws + OFF_RSTD0);
        for (int g = gw; g < NTOK; g += nw) {
            const float* src = tok_xrow(p, g);
            bf16_t* dst = g < 16384 ? (bf16_t*)(p.out + O_SS) + (size_t)g * 1024 : (bf16_t*)(p.ws + OFF_XNB) + (size_t)(g - 16384) * 1024;
            float ss = 0.f;
#pragma unroll
            for (int j = 0; j < 4; ++j) {
                f32x4 v = *(const f32x4*)(src + j * 256 + lane * 4); ss += v[0] * v[0] + v[1] * v[1] + v[2] * v[2] + v[3] * v[3];
                u32x2 o; o[0] = cvtpk(v[0], v[1]); o[1] = cvtpk(v[2], v[3]);
                *(u32x2*)(dst + j * 256 + lane * 4) = o;
            }
            ss = wave_sum(ss);
            if (lane == 0) RS0[g] = rsqrtf(ss * (1.f / 1024.f) + 1e-6f);
        }
    }
}

__device__ void phase1(const Params& p, LAS unsigned char* lds, int tid) {
    const float* RS0 = (const float*)(p.ws + OFF_RSTD0);
    const bf16_t* WIN = (const bf16_t*)(p.ws + OFF_WIN);
    bf16_t* QKVG = (bf16_t*)(p.ws + OFF_QKVG);
    bf16_t* QKM = (bf16_t*)(p.ws + OFF_QKM);
    bf16_t* REST = (bf16_t*)(p.ws + OFF_REST);
    float* GATES = (float*)(p.ws + OFF_GATES);
    const int wid = tid >> 6, lane = tid & 63, wr = wid >> 1, wc = wid & 1, fr = lane & 15, fq = lane >> 4;
    int R[4], C[4];
#pragma unroll
    for (int i = 0; i < 4; ++i) stage_rc(tid * 16 + i * 4096, R[i], C[i]);
    LAS float* ctl = (LAS float*)lds;
    LAS float* ssq = (LAS float*)(lds + 66048);
    const bool xmap = (gridDim.x & 7) == 0;
    const int xg = blockIdx.x & 7, xs = blockIdx.x >> 3, xn = gridDim.x >> 3;
    for (int it = xmap ? xs : blockIdx.x; it < (xmap ? 594 : 144 * 33); it += (xmap ? xn : gridDim.x)) {
        int mt, cj;
        if (xmap) { if (it < 576) { mt = it >> 2; cj = xg + 8 * (it & 3); } else { mt = xg + 8 * (it - 576); cj = 32; } }
        else { mt = it / 33; cj = it - mt * 33; }
        const int ct = cj < 32 ? cj : 48;
        const bool sample = mt >= 136;
        const int b = mt / 17, ti = mt - b * 17;
        auto tok_of_row = [&](int r) -> int {
            if (sample) return NPROMPT_TOK + (mt - 136) * 128 + r;
            int t = 125 * ti - 3 + r; return (t >= 0 && t < LP) ? b * LP + t : -1; };
        const bf16_t* ap[2]; const bf16_t* bp[2];
#pragma unroll
        for (int i = 0; i < 2; ++i) {
            int Rr, Cc; dma4_rc(tid, i, Rr, Cc);
            const int g = tok_of_row(Rr);
            const bf16_t* xr = g < 0 ? (const bf16_t*)(p.ws + OFF_ZROW) : (g < 16384 ? (const bf16_t*)(p.out + O_SS) + (size_t)g * 1024 : (const bf16_t*)(p.ws + OFF_XNB) + (size_t)(g - 16384) * 1024);
            ap[i] = xr + Cc; bp[i] = WIN + (size_t)(ct * 128 + Rr) * 1024 + Cc;
        }
        f32x4 acc[4][4];
        ACC_ZERO(acc);
        gemm_core_dma4(ap, bp, 32, lds, acc, tid);
#pragma unroll
        for (int m = 0; m < 4; ++m) {
            const int g = tok_of_row(wr * 64 + m * 16 + fr);
            const float rs = g >= 0 ? RS0[g] : 0.f;
#pragma unroll
            for (int n = 0; n < 4; ++n) acc[m][n] *= rs;
        }
        if (ct < 20) {
            __syncthreads();
#pragma unroll
            for (int m = 0; m < 4; ++m)
#pragma unroll
                for (int n = 0; n < 4; ++n)
#pragma unroll
                    for (int j = 0; j < 4; ++j) ctl[(wr * 64 + m * 16 + fr) * 129 + wc * 64 + n * 16 + fq * 4 + j] = acc[m][n][j];
            __syncthreads();
            const bool gdn = ct < 12; const int cc0 = gdn ? ct * 128 : (ct - 12) * 128; const int CD = gdn ? 1536 : 1024;
            if (!sample && ti == 16) {
                float* dst = p.out + (gdn ? O_PCONV : O_PMCONV) + (size_t)b * 3 * CD;
                for (int idx = tid; idx < 384; idx += 256) { int rr = idx >> 7, c = idx & 127; dst[rr * CD + cc0 + c] = ctl[(64 + rr) * 129 + c]; }
            }
            if (sample) {
                float* dst = p.out + (gdn ? O_SCONV : O_SMCONV);
                for (int idx = tid; idx < 16 * 384; idx += 256) {
                    int s = idx / 384, rem = idx - s * 384, rr = rem >> 7, c = rem & 127, bs = (mt - 136) * 16 + s;
                    dst[((size_t)bs * 3 + rr) * CD + cc0 + c] = ctl[(s * 8 + 5 + rr) * 129 + c];
                }
            }
            {
                const int c = tid & 127, half = tid >> 7;
                const float* cw = gdn ? p.in[11] : p.in[15];
                const float w0 = cw[0 * CD + cc0 + c], w1 = cw[1 * CD + cc0 + c], w2 = cw[2 * CD + cc0 + c], w3 = cw[3 * CD + cc0 + c];
                if (!sample) {
                    const int r0 = half ? 64 : 3, r1 = half ? 128 : 64;
                    float x3 = ctl[(r0 - 3) * 129 + c], x2 = ctl[(r0 - 2) * 129 + c], x1 = ctl[(r0 - 1) * 129 + c];
                    __syncthreads();
                    for (int r = r0; r < r1; ++r) {
                        float x0 = ctl[r * 129 + c];
                        float y = w0 * x3 + w1 * x2 + w2 * x1 + w3 * x0;
                        ctl[r * 129 + c] = siluf_(y);
                        x3 = x2; x2 = x1; x1 = x0;
                    }
                } else {
                    const float* st = gdn ? p.in[3] : p.in[7];
                    __syncthreads();
                    for (int s = half * 8; s < half * 8 + 8; ++s) {
                        const int bs = (mt - 136) * 16 + s;
                        float x3 = st[((size_t)bs * 3 + 0) * CD + cc0 + c], x2 = st[((size_t)bs * 3 + 1) * CD + cc0 + c], x1 = st[((size_t)bs * 3 + 2) * CD + cc0 + c];
                        for (int q = 0; q < 8; ++q) {
                            const int r = s * 8 + q;
                            float x0 = ctl[r * 129 + c];
                            float y = w0 * x3 + w1 * x2 + w2 * x1 + w3 * x0;
                            ctl[r * 129 + c] = siluf_(y);
                            x3 = x2; x2 = x1; x1 = x0;
                        }
                    }
                }
            }
            __syncthreads();
            const int row = tid & 127, hf = tid >> 7;
            float rs = 1.f;
            if (ct < 8) {
                float s = 0.f;
                for (int i = 0; i < 64; ++i) { float v = ctl[row * 129 + hf * 64 + i]; s += v * v; }
                ssq[hf * 128 + row] = s;
                __syncthreads();
                rs = rsqrtf(ssq[row] + ssq[128 + row] + 1e-6f);
                if (ct < 4) rs *= 0.08838834764831845f;
            } else if (ct >= 16) rs = 0.08838834764831845f;
            const int g = tok_of_row(row);
            const bool valid = sample || (row >= 3 && g >= 0);
            if (valid) {
                bf16_t* dst = (gdn ? QKVG + (size_t)g * 1536 : QKM + (size_t)g * 1024) + cc0 + hf * 64;
                for (int i = 0; i < 64; i += 8) {
                    float v[8];
#pragma unroll
                    for (int q = 0; q < 8; ++q) v[q] = ctl[row * 129 + hf * 64 + i + q] * rs;
                    u32x4 o; o[0] = cvtpk(v[0], v[1]); o[1] = cvtpk(v[2], v[3]); o[2] = cvtpk(v[4], v[5]); o[3] = cvtpk(v[6], v[7]);
                    *(u32x4*)(dst + i) = o;
                }
            }
            __syncthreads();
        } else if (ct < 48) {
            const int mode = ct < 24 ? 0 : (ct < 28 ? 1 : 2);
#pragma unroll
            for (int m = 0; m < 4; ++m) {
                const int row = wr * 64 + m * 16 + fr; const int g = tok_of_row(row);
                const bool valid = sample || (row >= 3 && g >= 0);
                if (!valid) continue;
                bf16_t* dst = REST + (size_t)g * RESTW + (ct - 20) * 128 + wc * 64 + fq * 4;
#pragma unroll
                for (int n = 0; n < 4; ++n) {
                    f32x4 v = acc[m][n];
                    if (mode == 1) { for (int j = 0; j < 4; ++j) v[j] = siluf_(v[j]); }
                    else if (mode == 2) { for (int j = 0; j < 4; ++j) v[j] = sigmoidf_(v[j]); }
                    u32x2 o; o[0] = cvtpk(v[0], v[1]); o[1] = cvtpk(v[2], v[3]);
                    *(u32x2*)(dst + n * 16) = o;
                }
            }
        } else {
            if (wc == 0) {
#pragma unroll
                for (int m = 0; m < 4; ++m) {
                    const int row = wr * 64 + m * 16 + fr; const int g = tok_of_row(row);
                    const bool valid = sample || (row >= 3 && g >= 0);
                    if (!valid) continue;
                    f32x4 v = acc[m][0], o;
#pragma unroll
                    for (int j = 0; j < 4; ++j) {
                        float x = v[j], r;
                        if (fq == 0) r = __expf(-__expf(p.in[12][j]) * softplusf_(x + p.in[13][j]));
                        else if (fq == 1) r = sigmoidf_(x);
                        else if (fq == 2) r = x + p.in[16][j];
                        else { float z = x + p.in[17][j]; r = -softplusf_(-z); }
                        o[j] = r;
                    }
                    *(f32x4*)(GATES + (size_t)g * 16 + fq * 4) = o;
                }
            }
        }
    }
}

__device__ __forceinline__ float row8_sum(float x) { x += dppf<0x141>(x); x += dppf<0x4E>(x); x += dppf<0xB1>(x); return x; }

template <int MIX>
__device__ void scan_unit(const Params& p, LAS unsigned char* lds, int tid, int b, int h, int rg, bool sample) {
    const int T = sample ? 8 : LP;
    const size_t g0 = sample ? (size_t)NPROMPT_TOK + b * 8 : (size_t)b * LP;
    const int wave = tid >> 6, lane = tid & 63, rr = lane >> 3, kq = lane & 7;
    const int row32 = wave * 8 + rr, row = rg * 32 + row32;
    const bf16_t* QKVG = (const bf16_t*)(p.ws + OFF_QKVG);
    const bf16_t* QKM = (const bf16_t*)(p.ws + OFF_QKM);
    const bf16_t* REST = (const bf16_t*)(p.ws + OFF_REST);
    const float* GATES = (const float*)(p.ws + OFF_GATES);
    bf16_t* oraw = (bf16_t*)(p.ws + OFF_ORAW);
    f32x2 S[8], nv[8]; float mrun = 0.f;
#pragma unroll
    for (int i = 0; i < 8; ++i) { S[i] = f32x2{0.f, 0.f}; nv[i] = f32x2{0.f, 0.f}; }
    if (sample) {
        const float* s0 = (MIX == 0 ? p.in[2] : p.in[4]) + ((size_t)(b * 4 + h) * 128 + row) * 128 + kq * 16;
#pragma unroll
        for (int c = 0; c < 4; ++c) { const f32x4 a = *(const f32x4*)(s0 + c * 4); S[c * 2] = f32x2{a[0], a[1]}; S[c * 2 + 1] = f32x2{a[2], a[3]}; }
        if (MIX == 1) {
            const float* n0 = p.in[5] + (size_t)(b * 4 + h) * 128 + kq * 16;
#pragma unroll
            for (int c = 0; c < 4; ++c) { const f32x4 a = *(const f32x4*)(n0 + c * 4); nv[c * 2] = f32x2{a[0], a[1]}; nv[c * 2 + 1] = f32x2{a[2], a[3]}; }
            mrun = p.in[6][b * 4 + h];
        }
    }
    LAS float* kbuf = (LAS float*)lds;
    LAS float* qbuf = (LAS float*)(lds + 16384);
    LAS float* vbuf = (LAS float*)(lds + 32768);
    LAS float* g1 = (LAS float*)(lds + 36864);
    LAS float* g2 = (LAS float*)(lds + 36992);
    LAS float* obuf = (LAS float*)(lds + 37120);
    __syncthreads();
    for (int t0 = 0; t0 < T; t0 += 32) {
        const int nt = min(32, T - t0);
        {
            const int tt = tid >> 3, part = tid & 7;
            if (tt < nt) {
                const size_t g = g0 + t0 + tt;
                const bf16_t* qs; const bf16_t* ks;
                if (MIX == 0) { qs = QKVG + g * 1536 + h * 128 + part * 16; ks = qs + 512; }
                else { qs = QKM + g * 1024 + h * 128 + part * 16; ks = qs + 512; }
                u32x4 k0 = *(const u32x4*)ks, k1 = *(const u32x4*)(ks + 8), q0 = *(const u32x4*)qs, q1 = *(const u32x4*)(qs + 8);
                LAS f32x4* kd = (LAS f32x4*)(kbuf + tt * 128 + part * 16);
                LAS f32x4* qd = (LAS f32x4*)(qbuf + tt * 128 + part * 16);
                kd[0] = f32x4{bflo(k0[0]), bfhi(k0[0]), bflo(k0[1]), bfhi(k0[1])}; kd[1] = f32x4{bflo(k0[2]), bfhi(k0[2]), bflo(k0[3]), bfhi(k0[3])};
                kd[2] = f32x4{bflo(k1[0]), bfhi(k1[0]), bflo(k1[1]), bfhi(k1[1])}; kd[3] = f32x4{bflo(k1[2]), bfhi(k1[2]), bflo(k1[3]), bfhi(k1[3])};
                qd[0] = f32x4{bflo(q0[0]), bfhi(q0[0]), bflo(q0[1]), bfhi(q0[1])}; qd[1] = f32x4{bflo(q0[2]), bfhi(q0[2]), bflo(q0[3]), bfhi(q0[3])};
                qd[2] = f32x4{bflo(q1[0]), bfhi(q1[0]), bflo(q1[1]), bfhi(q1[1])}; qd[3] = f32x4{bflo(q1[2]), bfhi(q1[2]), bflo(q1[3]), bfhi(q1[3])};
            }
            if (tid < 128) {
                const int t2 = tid >> 2, hv = tid & 3;
                if (t2 < nt) {
                    const size_t g = g0 + t0 + t2;
                    const bf16_t* vs = (MIX == 0 ? QKVG + g * 1536 + 1024 : REST + g * RESTW) + h * 128 + rg * 32 + hv * 8;
                    u32x4 v0 = *(const u32x4*)vs;
                    LAS f32x4* vd = (LAS f32x4*)(vbuf + t2 * 32 + hv * 8);
                    vd[0] = f32x4{bflo(v0[0]), bfhi(v0[0]), bflo(v0[1]), bfhi(v0[1])}; vd[1] = f32x4{bflo(v0[2]), bfhi(v0[2]), bflo(v0[3]), bfhi(v0[3])};
                }
            } else if (tid < 160) {
                const int t2 = tid - 128;
                if (t2 < nt) { const size_t g = g0 + t0 + t2; g1[t2] = GATES[g * 16 + (MIX ? 8 : 0) + h]; g2[t2] = GATES[g * 16 + (MIX ? 12 : 4) + h]; }
            }
        }
        __syncthreads();
#pragma unroll 2
        for (int tt = 0; tt < nt; ++tt) {
            f32x2 k2[8], q2[8];
#pragma unroll
            for (int c = 0; c < 4; ++c) {
                const f32x4 ka = *(const LAS f32x4*)(kbuf + tt * 128 + kq * 16 + c * 4), qa = *(const LAS f32x4*)(qbuf + tt * 128 + kq * 16 + c * 4);
                k2[c * 2] = f32x2{ka[0], ka[1]}; k2[c * 2 + 1] = f32x2{ka[2], ka[3]};
                q2[c * 2] = f32x2{qa[0], qa[1]}; q2[c * 2 + 1] = f32x2{qa[2], qa[3]};
            }
            const float vt = vbuf[tt * 32 + row32];
            const float ga = g1[tt], gb = g2[tt];
            float o;
            if (MIX == 0) {
                f32x2 pr = S[0] * k2[0], pr2 = S[1] * k2[1];
#pragma unroll
                for (int i = 2; i < 8; i += 2) { pr = S[i] * k2[i] + pr; pr2 = S[i + 1] * k2[i + 1] + pr2; }
                pr = pr + pr2;
                const float r = row8_sum(pr[0] + pr[1]);
                const float coef = gb * (vt - ga * r);
                const f32x2 c2 = f32x2{coef, coef}, a2 = f32x2{ga, ga};
#pragma unroll
                for (int i = 0; i < 8; ++i) S[i] = a2 * S[i] + c2 * k2[i];
                f32x2 po = S[0] * q2[0], po2 = S[1] * q2[1];
#pragma unroll
                for (int i = 2; i < 8; i += 2) { po = S[i] * q2[i] + po; po2 = S[i + 1] * q2[i + 1] + po2; }
                po = po + po2;
                o = row8_sum(po[0] + po[1]);
            } else {
                const float mn = fmaxf(gb + mrun, ga);
                const float fd = __expf(gb + mrun - mn), iw = __expf(ga - mn);
                mrun = mn;
                const float iv = iw * vt;
                const f32x2 f2 = f32x2{fd, fd}, i2 = f32x2{iv, iv}, w2 = f32x2{iw, iw};
#pragma unroll
                for (int i = 0; i < 8; ++i) { S[i] = f2 * S[i] + i2 * k2[i]; nv[i] = f2 * nv[i] + w2 * k2[i]; }
                f32x2 pn = S[0] * q2[0], pd = nv[0] * q2[0];
#pragma unroll
                for (int i = 1; i < 8; ++i) { pn = S[i] * q2[i] + pn; pd = nv[i] * q2[i] + pd; }
                const float num = row8_sum(pn[0] + pn[1]), den = row8_sum(pd[0] + pd[1]);
                o = num * __builtin_amdgcn_rcpf(fmaxf(fabsf(den), __expf(-mn)));
            }
            obuf[tt * 32 + row32] = o;
        }
        __syncthreads();
        {
            const int tt = tid >> 3, part = tid & 7;
            if (tt < nt) {
                const int t = t0 + tt;
                if (sample || t >= 16) {
                    const size_t yrow = sample ? (size_t)16384 + b * 8 + t : (size_t)b * 2048 + (t - 16);
                    const f32x4 ov = *(const LAS f32x4*)(obuf + tt * 32 + part * 4);
                    u32x2 ow; ow[0] = cvtpk(ov[0], ov[1]); ow[1] = cvtpk(ov[2], ov[3]);
                    *(u32x2*)(oraw + yrow * 1024 + MIX * 512 + h * 128 + rg * 32 + part * 4) = ow;
                }
            }
        }
    }
    {
        float* sd = p.out + (sample ? (MIX == 0 ? O_SS : O_SC) : (MIX == 0 ? O_PS : O_PC)) + ((size_t)(b * 4 + h) * 128 + row) * 128 + kq * 16;
#pragma unroll
        for (int c = 0; c < 4; ++c) *(f32x4*)(sd + c * 4) = f32x4{S[c * 2][0], S[c * 2][1], S[c * 2 + 1][0], S[c * 2 + 1][1]};
        if (MIX == 1 && rg == 0 && wave == 0 && rr == 0) {
            float* nd = p.out + (sample ? O_SN : O_PN) + (size_t)(b * 4 + h) * 128 + kq * 16;
#pragma unroll
            for (int c = 0; c < 4; ++c) *(f32x4*)(nd + c * 4) = f32x4{nv[c * 2][0], nv[c * 2][1], nv[c * 2 + 1][0], nv[c * 2 + 1][1]};
            if (kq == 0) p.out[(sample ? O_SM : O_PM) + b * 4 + h] = mrun;
        }
    }
    __syncthreads();
}

__device__ void phase2(const Params& p, LAS unsigned char* lds, int tid) {
    auto run_prompt = [&](int u) {
        const int mix = u >> 7, v = u & 127, b = v >> 4, h = (v >> 2) & 3, rg = v & 3;
        if (mix == 0) scan_unit<0>(p, lds, tid, b, h, rg, false); else scan_unit<1>(p, lds, tid, b, h, rg, false);
    };
    auto run_sample = [&](int w) {
        const int mix = w >> 11, v = w & 2047, b = v >> 4, h = (v >> 2) & 3, rg = v & 3;
        if (mix == 0) scan_unit<0>(p, lds, tid, b, h, rg, true); else scan_unit<1>(p, lds, tid, b, h, rg, true);
    };
    if (gridDim.x >= 512) {
        if (blockIdx.x < 256) run_prompt(blockIdx.x);
        else if (blockIdx.x < 384) {
            for (int w = blockIdx.x - 256; w < 4096; w += 128) run_sample(w);
        }
    } else {
        for (int u = blockIdx.x; u < 256 + 4096; u += gridDim.x) { if (u < 256) run_prompt(u); else run_sample(u - 256); }
    }
}

__device__ void phase3(const Params& p, int tid) {
    const int lane = tid & 63, gw = blockIdx.x * 4 + (tid >> 6), nw = gridDim.x * 4;
    const bf16_t* ORAW = (const bf16_t*)(p.ws + OFF_ORAW);
    float* RSH = (float*)(p.ws + OFF_RSTDH);
    for (int yrow = gw; yrow < NY; yrow += nw) {
#pragma unroll
        for (int j = 0; j < 4; ++j) {
            const u32x2 w = *(const u32x2*)(ORAW + (size_t)yrow * 1024 + j * 256 + lane * 4);
            const float a0 = bflo(w[0]), a1 = bfhi(w[0]), a2 = bflo(w[1]), a3 = bfhi(w[1]);
            float ss = a0 * a0 + a1 * a1 + a2 * a2 + a3 * a3;
            ss = half32_sum(ss);
            if ((lane & 31) == 0) RSH[(size_t)yrow * 8 + (j >> 1) * 4 + (j & 1) * 2 + (lane >> 5)] = rsqrtf(ss * (1.f / 128.f) + 1e-6f);
        }
    }
}

__device__ void phase4(const Params& p, LAS unsigned char* lds, int tid) {
    const bf16_t* ORAW = (const bf16_t*)(p.ws + OFF_ORAW);
    const bf16_t* WB = (const bf16_t*)(p.ws + OFF_WB);
    const bf16_t* WIN = (const bf16_t*)(p.ws + OFF_WIN);
    const bf16_t* REST = (const bf16_t*)(p.ws + OFF_REST);
    const float* RS0 = (const float*)(p.ws + OFF_RSTD0);
    const float* RSH = (const float*)(p.ws + OFF_RSTDH);
    bf16_t* MERGED = (bf16_t*)(p.ws + OFF_MERGED);
    const int wid = tid >> 6, lane = tid & 63, wr = wid >> 1, wc = wid & 1, fr = lane & 15, fq = lane >> 4;
    int R[4], C[4];
#pragma unroll
    for (int i = 0; i < 4; ++i) stage_rc(tid * 16 + i * 4096, R[i], C[i]);
    const bool xmap = (gridDim.x & 7) == 0;
    const int xg = blockIdx.x & 7, xs = blockIdx.x >> 3, xn = gridDim.x >> 3;
    for (int it = xmap ? xs : blockIdx.x; it < (xmap ? 272 : 136 * 16); it += (xmap ? xn : gridDim.x)) {
        const int mt = xmap ? (it >> 1) : (it >> 4), ct = xmap ? (xg + 8 * (it & 1)) : (it & 15);
        ASrc ax, ao; const bf16_t* bp[4];
        f32x4 acc[4][2];
        u32x2 pg2[2][4][2];
        LAS u32x4* pal = (LAS u32x4*)(lds + 65536 + tid * 16);
        ax.b0 = (const char*)(mt < 128 ? p.in[0] : p.in[1]);
#pragma unroll
        for (int i = 0; i < 4; ++i) ax.o0[i] = (unsigned)(((mt < 128 ? mt : mt - 128) * 128 + R[i]) * 1024 + C[i]) * 4u;
        ao.b0 = (const char*)ORAW; ao.b1 = (const char*)REST; ao.b2 = (const char*)RSH;
        {
            f32x4 accg[4][4];
#pragma unroll
            for (int i = 0; i < 4; ++i) {
                const int r = R[i], wcg = r >> 6, w = r & 63, gsel = w >> 5, col = wcg * 32 + (w & 31);
                bp[i] = WIN + (size_t)(4096 + gsel * 1024 + ct * 64 + col) * 1024 + C[i];
            }
            ACC_ZERO(accg);
            gemm_core2<3, 4>(ax, bp, 16, lds, accg, tid);
#pragma unroll
            for (int m = 0; m < 4; ++m) {
                const float r0 = RS0[yrow_to_tok(mt * 128 + wr * 64 + m * 16 + fr)];
#pragma unroll
                for (int n = 0; n < 4; ++n) {
                    const f32x4 v = accg[m][n];
                    pg2[n >> 1][m][n & 1][0] = cvtpk(sigmoidf_(v[0] * r0), sigmoidf_(v[1] * r0));
                    pg2[n >> 1][m][n & 1][1] = cvtpk(sigmoidf_(v[2] * r0), sigmoidf_(v[3] * r0));
                }
            }
        }
#pragma unroll
        for (int pass = 0; pass < 2; ++pass) {
#pragma unroll
            for (int i = 0; i < 4; ++i) {
                const int yr = mt * 128 + R[i]; const int g = yrow_to_tok(yr);
                ao.o0[i] = (unsigned)(yr * 1024 + pass * 512 + C[i]) * 2u;
                ao.o1[i] = (unsigned)(g * RESTW + 512 + pass * 512 + C[i]) * 2u;
                ao.o2[i] = (unsigned)(yr * 8 + pass * 4) * 4u;
                bp[i] = WB + (size_t)(ct * 64 + (R[i] & 63)) * 1024 + pass * 512 + C[i];
            }
            ACC_ZERO2(acc);
            gemm_core2<4, 2>(ao, bp, 8, lds, acc, tid);
            if (pass == 0) {
#pragma unroll
                for (int m = 0; m < 4; ++m) {
                    u32x4 w;
#pragma unroll
                    for (int n = 0; n < 2; ++n) {
                        const f32x4 v = acc[m][n];
                        w[n * 2] = cvtpk(v[0] * bflo(pg2[pass][m][n][0]), v[1] * bfhi(pg2[pass][m][n][0]));
                        w[n * 2 + 1] = cvtpk(v[2] * bflo(pg2[pass][m][n][1]), v[3] * bfhi(pg2[pass][m][n][1]));
                    }
                    pal[m * 256] = w;
                }
            } else {
#pragma unroll
                for (int m = 0; m < 4; ++m) {
                    const int yrow = mt * 128 + wr * 64 + m * 16 + fr;
                    bf16_t* dst = MERGED + (size_t)yrow * 1024 + ct * 64 + wc * 32 + fq * 4;
                    const u32x4 w = pal[m * 256];
#pragma unroll
                    for (int n = 0; n < 2; ++n) {
                        const f32x4 v = acc[m][n];
                        u32x2 o;
                        o[0] = cvtpk(bflo(w[n * 2]) + v[0] * bflo(pg2[pass][m][n][0]), bfhi(w[n * 2]) + v[1] * bfhi(pg2[pass][m][n][0]));
                        o[1] = cvtpk(bflo(w[n * 2 + 1]) + v[2] * bflo(pg2[pass][m][n][1]), bfhi(w[n * 2 + 1]) + v[3] * bfhi(pg2[pass][m][n][1]));
                        *(u32x2*)(dst + n * 16) = o;
                    }
                }
            }
        }
    }
}

__device__ void phase5(const Params& p, LAS unsigned char* lds, int tid) {
    const bf16_t* MERGED = (const bf16_t*)(p.ws + OFF_MERGED);
    const bf16_t* WO = (const bf16_t*)(p.ws + OFF_WO);
    float* H2 = p.out + O_Y;
    const int wid = tid >> 6, lane = tid & 63, wr = wid >> 1, wc = wid & 1, fr = lane & 15, fq = lane >> 4;
    int R[4], C[4];
#pragma unroll
    for (int i = 0; i < 4; ++i) stage_rc(tid * 16 + i * 4096, R[i], C[i]);
    for (int tile = blockIdx.x; tile < 136 * 8; tile += gridDim.x) {
        const int mt = tile >> 3, ct = tile & 7;
        const bf16_t* ap[2]; const bf16_t* bp[2];
#pragma unroll
        for (int i = 0; i < 2; ++i) { int Rr, Cc; dma4_rc(tid, i, Rr, Cc); ap[i] = MERGED + (size_t)(mt * 128 + Rr) * 1024 + Cc; bp[i] = WO + (size_t)(ct * 128 + Rr) * 1024 + Cc; }
        f32x4 acc[4][4];
        ACC_ZERO(acc);
        gemm_core_dma4(ap, bp, 32, lds, acc, tid);
#pragma unroll
        for (int m = 0; m < 4; ++m) {
            const int yrow = mt * 128 + wr * 64 + m * 16 + fr;
            const float* hs = yrow_xrow(p, yrow) + ct * 128 + wc * 64 + fq * 4;
            float* dst = H2 + (size_t)yrow * 1024 + ct * 128 + wc * 64 + fq * 4;
#pragma unroll
            for (int n = 0; n < 4; ++n) {
                f32x4 hv = *(const f32x4*)(hs + n * 16);
                f32x4 v = acc[m][n];
                *(f32x4*)(dst + n * 16) = f32x4{hv[0] + v[0], hv[1] + v[1], hv[2] + v[2], hv[3] + v[3]};
            }
        }
    }
}

__device__ void phase5b(const Params& p, int tid) {
    const int lane = tid & 63, gw = blockIdx.x * 4 + (tid >> 6), nw = gridDim.x * 4;
    const float* H2 = p.out + O_Y;
    float* RS2 = (float*)(p.ws + OFF_RSTD2);
    for (int yrow = gw; yrow < NY; yrow += nw) {
        const float* src = H2 + (size_t)yrow * 1024;
        float ss = 0.f;
#pragma unroll
        for (int j = 0; j < 4; ++j) { f32x4 v = *(const f32x4*)(src + j * 256 + lane * 4); ss += v[0] * v[0] + v[1] * v[1] + v[2] * v[2] + v[3] * v[3]; }
        ss = wave_sum(ss);
        if (lane == 0) RS2[yrow] = rsqrtf(ss * (1.f / 1024.f) + 1e-6f);
    }
}

__device__ __forceinline__ void topk_keys(float a, float bq, int lane, unsigned& ka, unsigned& kb) {
    ka = __float_as_uint(a); kb = __float_as_uint(bq);
    ka ^= (ka & 0x80000000u) ? 0xffffffffu : 0x80000000u;
    kb ^= (kb & 0x80000000u) ? 0xffffffffu : 0x80000000u;
    ka = (ka & ~127u) | (unsigned)(127 - lane);
    kb = (kb & ~127u) | (unsigned)(63 - lane);
}
__device__ __forceinline__ void topk_finish(unsigned ka, unsigned kb, unsigned T, int lane, float& outv, int& outi) {
    unsigned long long ma = __ballot(ka >= T), mb = __ballot(kb >= T);
    unsigned mykey = 0u;
#pragma nounroll
    for (int i = 0; i < 16; ++i) {
        unsigned kj;
        if (ma != 0ull) { const int L = __builtin_ctzll(ma); ma &= ma - 1ull; kj = (unsigned)__builtin_amdgcn_readlane((int)ka, L); }
        else { const int L = __builtin_ctzll(mb); mb &= mb - 1ull; kj = (unsigned)__builtin_amdgcn_readlane((int)kb, L); }
        if (lane == i) mykey = kj;
    }
    int rk = 0;
#pragma unroll
    for (int j = 0; j < 16; ++j) { const unsigned kj = (unsigned)__builtin_amdgcn_readlane((int)mykey, j); rk += (kj > mykey) ? 1 : 0; }
    const int dstl = lane < 16 ? rk : lane;
    const unsigned sk = (unsigned)__builtin_amdgcn_ds_permute(dstl * 4, (int)mykey);
    const unsigned fb = (sk & 0x80000000u) ? (sk ^ 0x80000000u) : ~sk;
    outv = __uint_as_float(fb);
    outi = 127 - (int)(sk & 127u);
}
__device__ __forceinline__ void topk16_pair(float a0, float b0, float a1, float b1, int lane, float& ov0, int& oi0, float& ov1, int& oi1) {
    unsigned ka0, kb0, ka1, kb1;
    topk_keys(a0, b0, lane, ka0, kb0); topk_keys(a1, b1, lane, ka1, kb1);
    unsigned T0 = 0u, T1 = 0u;
#pragma unroll 4
    for (int bit = 31; bit >= 0; --bit) {
        const unsigned c0 = T0 | (1u << bit), c1 = T1 | (1u << bit);
        const int n0 = __builtin_popcountll(__ballot(ka0 >= c0)) + __builtin_popcountll(__ballot(kb0 >= c0));
        const int n1 = __builtin_popcountll(__ballot(ka1 >= c1)) + __builtin_popcountll(__ballot(kb1 >= c1));
        if (n0 >= 16) T0 = c0;
        if (n1 >= 16) T1 = c1;
    }
    topk_finish(ka0, kb0, T0, lane, ov0, oi0);
    topk_finish(ka1, kb1, T1, lane, ov1, oi1);
}

__device__ void phase6(const Params& p, LAS unsigned char* lds, int tid) {
    const float* H2 = p.out + O_Y;
    const bf16_t* WQ = (const bf16_t*)(p.ws + OFF_WQ);
    const bf16_t* KEYSB = (const bf16_t*)(p.ws + OFF_KEYS);
    const float* RS2 = (const float*)(p.ws + OFF_RSTD2);
    bf16_t* SVB = (bf16_t*)(p.ws + OFF_SVB);
    unsigned char* SIB = (unsigned char*)(p.ws + OFF_SIB);
    const int wid = tid >> 6, lane = tid & 63, wr = wid >> 1, wc = wid & 1, fr = lane & 15, fq = lane >> 4;
    int R[4], C[4];
#pragma unroll
    for (int i = 0; i < 4; ++i) stage_rc(tid * 16 + i * 4096, R[i], C[i]);
    const bool xmap = (gridDim.x & 7) == 0;
    const int xg = blockIdx.x & 7, xs = blockIdx.x >> 3, xn = gridDim.x >> 3;
    for (int it = xmap ? xs : blockIdx.x; it < (xmap ? 272 : 136 * 16); it += (xmap ? xn : gridDim.x)) {
        const int mt = xmap ? (it >> 1) : (it >> 4), hp = xmap ? (xg + 8 * (it & 1)) : (it & 15);
        ASrc as; const bf16_t* bp[4];
#pragma unroll
        for (int i = 0; i < 4; ++i) { as.a[i] = H2 + (size_t)(mt * 128 + R[i]) * 1024 + C[i]; bp[i] = WQ + (size_t)(hp * 128 + R[i]) * 1024 + C[i]; }
        f32x4 acc[4][4];
        ACC_ZERO(acc);
        gemm_core2<1>(as, bp, 16, lds, acc, tid);
        __syncthreads();
#pragma unroll
        for (int m = 0; m < 4; ++m) {
            const int r = wr * 64 + m * 16 + fr;
            const float rs = RS2[mt * 128 + r];
#pragma unroll
            for (int n = 0; n < 4; ++n) {
                const f32x4 v = acc[m][n];
                u32x2 o; o[0] = cvtpk(v[0] * rs, v[1] * rs); o[1] = cvtpk(v[2] * rs, v[3] * rs);
                *(LAS u32x2*)(lds + wc * 32768 + lds_byte(r, n * 16 + fq * 4)) = o;
            }
        }
#pragma unroll
        for (int t = 0; t < 2; ++t)
#pragma unroll
            for (int i = 0; i < 4; ++i)
                __builtin_amdgcn_global_load_lds((const unsigned*)(KEYSB + (size_t)(hp * 128 + R[i]) * 128 + C[i] + t * 64), (LAS unsigned*)(lds + t * 32768 + 16384 + tid * 16 + i * 4096), 16, 0, 0);
        asm volatile("s_waitcnt vmcnt(0)" ::: "memory");
        __syncthreads();
        ACC_ZERO(acc);
        {
            int aoff[2], boff[2];
#pragma unroll
            for (int k = 0; k < 2; ++k) { aoff[k] = lds_byte(wr * 64 + fr, k * 32 + fq * 8); boff[k] = lds_byte(wc * 64 + fr, k * 32 + fq * 8); }
#pragma unroll
            for (int t = 0; t < 2; ++t) {
                LAS unsigned char* sa = lds + t * 32768;
                LAS unsigned char* sb = sa + 16384;
#pragma unroll
                for (int k = 0; k < 2; ++k) {
                    bf16x8 af[4], bfr[4];
#pragma unroll
                    for (int m = 0; m < 4; ++m) af[m] = *(const LAS bf16x8*)(sa + aoff[k] + m * 2048);
#pragma unroll
                    for (int n = 0; n < 4; ++n) bfr[n] = *(const LAS bf16x8*)(sb + boff[k] + n * 2048);
#pragma unroll
                    for (int m = 0; m < 4; ++m)
#pragma unroll
                        for (int n = 0; n < 4; ++n) acc[m][n] = __builtin_amdgcn_mfma_f32_16x16x32_bf16(bfr[n], af[m], acc[m][n], 0, 0, 0);
                }
            }
        }
        __syncthreads();
        LAS float* sct = (LAS float*)lds;
#pragma unroll
        for (int m = 0; m < 4; ++m)
#pragma unroll
            for (int n = 0; n < 4; ++n)
#pragma unroll
                for (int j = 0; j < 4; ++j) sct[(wr * 64 + m * 16 + fr) * 129 + wc * 64 + n * 16 + fq * 4 + j] = acc[m][n][j];
        __syncthreads();
#pragma nounroll
        for (int rr = 0; rr < 32; rr += 2) {
            const int row = wid * 32 + rr;
            float ov0, ov1; int oi0, oi1;
            topk16_pair(sct[row * 129 + lane], sct[row * 129 + 64 + lane], sct[(row + 1) * 129 + lane], sct[(row + 1) * 129 + 64 + lane], lane, ov0, oi0, ov1, oi1);
            if (lane < 16) {
                const size_t o = ((size_t)(mt * 128 + row) * 16 + hp) * 16 + lane;
                SVB[o] = (bf16_t)(cvtpk(ov0, 0.f) & 0xffffu);
                SIB[o] = (unsigned char)oi0;
                SVB[o + 256] = (bf16_t)(cvtpk(ov1, 0.f) & 0xffffu);
                SIB[o + 256] = (unsigned char)oi1;
            }
        }
        __syncthreads();
    }
}

__device__ void phase8(const Params& p, int tid) {
    const int lane = tid & 63, gw = blockIdx.x * 4 + (tid >> 6), nw = gridDim.x * 4;
    float* Y = p.out + O_Y;
    const bf16_t* SVB = (const bf16_t*)(p.ws + OFF_SVB);
    const unsigned char* SIB = (const unsigned char*)(p.ws + OFF_SIB);
    const unsigned char* PUB = p.ws + OFF_PUB;
    const unsigned char* PVB = p.ws + OFF_PVB;
    int ci, cj;
    if (lane < 16) { ci = 0; cj = lane; } else if (lane < 24) { ci = 1; cj = lane - 16; } else if (lane < 29) { ci = 2; cj = lane - 24; } else if (lane < 33) { ci = 3; cj = lane - 29; }
    else if (lane < 36) { ci = 4; cj = lane - 33; } else if (lane < 38) { ci = 5; cj = lane - 36; } else if (lane < 40) { ci = 6; cj = lane - 38; } else if (lane < 42) { ci = 7; cj = lane - 40; }
    else if (lane < 50) { ci = lane - 34; cj = 0; } else { ci = 0; cj = 0; }
    const bool cvalid = lane < 50;
    const int cid = ci * 16 + cj;
    auto select = [&](unsigned sv01, unsigned si01, int& te, float& gate) {
        const float v0 = __uint_as_float(sv01 << 16), v1 = __uint_as_float(sv01 & 0xffff0000u);
        const int i0 = (int)(si01 & 0xffu), i1 = (int)(si01 >> 8);
        const float cv = __shfl(v0, ci) + __shfl(v1, cj);
        const int ecand = __shfl(i0, ci) * 128 + __shfl(i1, cj);
        unsigned key = __float_as_uint(cv);
        key ^= (key & 0x80000000u) ? 0xffffffffu : 0x80000000u;
        key = cvalid ? ((key & ~255u) | (unsigned)(255 - cid)) : 0u;
        int rk = 0;
#pragma unroll 10
        for (int j = 0; j < 50; ++j) { const unsigned kj = (unsigned)__builtin_amdgcn_readlane((int)key, j); rk += (kj > key) ? 1 : 0; }
        const int dstl = cvalid ? rk : lane;
        const unsigned sk = (unsigned)__builtin_amdgcn_ds_permute(dstl * 4, (int)key);
        te = __builtin_amdgcn_ds_permute(dstl * 4, ecand) & 16383;
        const unsigned fb = (sk & 0x80000000u) ? (sk ^ 0x80000000u) : ~sk;
        const float tv = __uint_as_float(fb);
        const float mx = __int_as_float(__builtin_amdgcn_readlane(__float_as_int(tv), 0));
        const float ex = lane < 16 ? __expf(tv - mx) : 0.f;
        gate = ex / wave_sum(ex);
    };
    for (int yrow = gw; yrow < NY; yrow += nw) {
        float* hrow = Y + (size_t)yrow * 1024;
        const size_t svbase = (size_t)yrow * 256 + (lane & 15);
        unsigned svn = (unsigned)SVB[svbase] | ((unsigned)SVB[svbase + 16] << 16);
        unsigned sin_ = (unsigned)SIB[svbase] | ((unsigned)SIB[svbase + 16] << 8);
        float hv[16], x[16], ya[16]; float ss = 0.f;
#pragma unroll
        for (int jj = 0; jj < 2; ++jj) {
            const f32x4 a = *(const f32x4*)(hrow + lane * 16 + jj * 8), b = *(const f32x4*)(hrow + lane * 16 + jj * 8 + 4);
#pragma unroll
            for (int k = 0; k < 4; ++k) { hv[jj * 8 + k] = a[k]; hv[jj * 8 + 4 + k] = b[k]; }
        }
#pragma unroll
        for (int i = 0; i < 16; ++i) { ss += hv[i] * hv[i]; ya[i] = 0.f; }
        ss = wave_sum(ss);
        {
            const float rstd = rsqrtf(ss * (1.f / 1024.f) + 1e-6f);
#pragma unroll
            for (int jj = 0; jj < 2; ++jj) {
                const f32x4 a = *(const f32x4*)(p.in[21] + lane * 16 + jj * 8), b = *(const f32x4*)(p.in[21] + lane * 16 + jj * 8 + 4);
#pragma unroll
                for (int k = 0; k < 4; ++k) { x[jj * 8 + k] = hv[jj * 8 + k] * rstd * a[k]; x[jj * 8 + 4 + k] = hv[jj * 8 + 4 + k] * rstd * b[k]; }
            }
        }
        int te_c; float gate_c;
        select(svn, sin_, te_c, gate_c);
        svn = (unsigned)SVB[svbase + 32] | ((unsigned)SVB[svbase + 48] << 16);
        sin_ = (unsigned)SIB[svbase + 32] | ((unsigned)SIB[svbase + 48] << 8);
#pragma nounroll
        for (int h = 0; h < 8; ++h) {
            int te_n = 0; float gate_n = 0.f;
            {
                u32x4 u0[8], u1[8], vv[8]; float wk[8];
#define LOADROWS(dst, TAB, k0) _Pragma("unroll") for (int g = 0; g < 8; ++g) { const int e = __builtin_amdgcn_readlane(te_c, (k0) + g) & 16383; dst[g] = *(const u32x4*)((TAB) + (size_t)e * 1024 + lane * 16); }
#define DOTS(src, k0) { float dd[8]; \
                    _Pragma("unroll") for (int g = 0; g < 8; ++g) { float d = 0.f; \
                        _Pragma("unroll") for (int q = 0; q < 4; ++q) { const f32x2 lo = __builtin_amdgcn_cvt_pk_f32_fp8((int)src[g][q], false), hi = __builtin_amdgcn_cvt_pk_f32_fp8((int)src[g][q], true); \
                            d += lo[0] * x[q * 4] + lo[1] * x[q * 4 + 1] + hi[0] * x[q * 4 + 2] + hi[1] * x[q * 4 + 3]; } \
                        dd[g] = d; } \
                      \
                    float e4[4], e2[2]; \
                    _Pragma("unroll") for (int j = 0; j < 4; ++j) { auto sw = __builtin_amdgcn_permlane32_swap(__float_as_uint(dd[j]), __float_as_uint(dd[j + 4]), false, false); e4[j] = __uint_as_float(sw[0]) + __uint_as_float(sw[1]); } \
                    _Pragma("unroll") for (int j = 0; j < 2; ++j) { auto sw = __builtin_amdgcn_permlane16_swap(__float_as_uint(e4[j]), __float_as_uint(e4[j + 2]), false, false); e2[j] = __uint_as_float(sw[0]) + __uint_as_float(sw[1]); } \
                    const float t0 = e2[0] + dppf<0x128>(e2[0]), t1 = e2[1] + dppf<0x128>(e2[1]); \
                    float e1 = (lane & 8) ? t1 : t0; \
                    e1 += dppf<0x141>(e1); e1 += dppf<0x4E>(e1); e1 += dppf<0xB1>(e1); \
                    const float dtot = e1 * (1.f / 256.f); \
                    const float act = 0.5f * dtot * (1.f + erff(dtot * 0.70710678118654752f)); \
                    const float wmine = __shfl(gate_c, (k0) + ((lane >> 3) & 7)) * act * (1.f / 64.f); \
                    _Pragma("unroll") for (int g = 0; g < 8; ++g) wk[g] = __int_as_float(__builtin_amdgcn_readlane(__float_as_int(wmine), ((g >> 2) & 1) * 32 + ((g >> 1) & 1) * 16 + (g & 1) * 8)); }
#define ACCUM() _Pragma("unroll") for (int g = 0; g < 8; ++g) { const float w = wk[g]; \
                    _Pragma("unroll") for (int q = 0; q < 4; ++q) { const f32x2 lo = __builtin_amdgcn_cvt_pk_f32_fp8((int)vv[g][q], false), hi = __builtin_amdgcn_cvt_pk_f32_fp8((int)vv[g][q], true); \
                        ya[q * 4] += w * lo[0]; ya[q * 4 + 1] += w * lo[1]; ya[q * 4 + 2] += w * hi[0]; ya[q * 4 + 3] += w * hi[1]; } }
                LOADROWS(u0, PUB, 0)
                if (h < 7) {
                    select(svn, sin_, te_n, gate_n);
                    if (h < 6) {
                        svn = (unsigned)SVB[svbase + (h + 2) * 32] | ((unsigned)SVB[svbase + (h + 2) * 32 + 16] << 16);
                        sin_ = (unsigned)SIB[svbase + (h + 2) * 32] | ((unsigned)SIB[svbase + (h + 2) * 32 + 16] << 8);
                    }
                }
                DOTS(u0, 0)
                LOADROWS(vv, PVB, 0)
                LOADROWS(u1, PUB, 8)
                ACCUM()
                DOTS(u1, 8)
                LOADROWS(vv, PVB, 8)
                ACCUM()
#undef LOADROWS
#undef DOTS
#undef ACCUM
            }
            te_c = te_n; gate_c = gate_n;
        }
        float s2 = 0.f;
#pragma unroll
        for (int jj = 0; jj < 2; ++jj) {
            const f32x4 a = *(const f32x4*)(hrow + lane * 16 + jj * 8), b = *(const f32x4*)(hrow + lane * 16 + jj * 8 + 4);
#pragma unroll
            for (int k = 0; k < 4; ++k) { hv[jj * 8 + k] = a[k] + ya[jj * 8 + k]; hv[jj * 8 + 4 + k] = b[k] + ya[jj * 8 + 4 + k]; }
        }
#pragma unroll
        for (int i = 0; i < 16; ++i) s2 += hv[i] * hv[i];
        s2 = wave_sum(s2);
        const float rstd2 = rsqrtf(s2 * (1.f / 1024.f) + 1e-6f);
#pragma unroll
        for (int jj = 0; jj < 2; ++jj) {
            const f32x4 a = *(const f32x4*)(p.in[26] + lane * 16 + jj * 8), b = *(const f32x4*)(p.in[26] + lane * 16 + jj * 8 + 4);
            *(f32x4*)(hrow + lane * 16 + jj * 8) = f32x4{hv[jj * 8 + 0] * rstd2 * a[0], hv[jj * 8 + 1] * rstd2 * a[1], hv[jj * 8 + 2] * rstd2 * a[2], hv[jj * 8 + 3] * rstd2 * a[3]};
            *(f32x4*)(hrow + lane * 16 + jj * 8 + 4) = f32x4{hv[jj * 8 + 4] * rstd2 * b[0], hv[jj * 8 + 5] * rstd2 * b[1], hv[jj * 8 + 6] * rstd2 * b[2], hv[jj * 8 + 7] * rstd2 * b[3]};
        }
    }
}

__device__ __forceinline__ void grid_barrier(unsigned* ctr, unsigned target) {
    asm volatile("s_waitcnt vmcnt(0)" ::: "memory");
    __syncthreads();
    if (threadIdx.x == 0) {
        __builtin_amdgcn_fence(__ATOMIC_RELEASE, "agent");
        asm volatile("s_waitcnt vmcnt(0)" ::: "memory");
        __hip_atomic_fetch_add(ctr, 1u, __ATOMIC_RELAXED, __HIP_MEMORY_SCOPE_AGENT);
        while (__hip_atomic_load(ctr, __ATOMIC_RELAXED, __HIP_MEMORY_SCOPE_AGENT) < target) __builtin_amdgcn_s_sleep(1);
        __builtin_amdgcn_fence(__ATOMIC_ACQUIRE, "agent");
        asm volatile("s_waitcnt vmcnt(0)" ::: "memory");
    }
    __syncthreads();
}
__device__ __forceinline__ void cg_sync_full(cg::grid_group& grid) {
    asm volatile("s_waitcnt vmcnt(0)" ::: "memory");
    grid.sync();
    if (threadIdx.x == 0) { __builtin_amdgcn_fence(__ATOMIC_ACQUIRE, "agent"); asm volatile("s_waitcnt vmcnt(0)" ::: "memory"); }
    __syncthreads();
}

__global__ void __launch_bounds__(256, 2) fwd_megakernel(Params p) {
    extern __shared__ __attribute__((aligned(16))) unsigned char lds_raw[];
    LAS unsigned char* lds = (LAS unsigned char*)lds_raw;
    cg::grid_group grid = cg::this_grid();
    const int tid = threadIdx.x;
    unsigned* bar = (unsigned*)(p.ws + OFF_BAR);
    const unsigned nb = gridDim.x;
    phase0(p, lds, tid);
    cg_sync_full(grid);
    phase1(p, lds, tid);
    grid_barrier(bar, nb * 1);
    phase2(p, lds, tid);
    grid_barrier(bar, nb * 2);
    phase3(p, tid);
    grid_barrier(bar, nb * 3);
    phase4(p, lds, tid);
    grid_barrier(bar, nb * 4);
    phase5(p, lds, tid);
    grid_barrier(bar, nb * 5);
    phase5b(p, tid);
    grid_barrier(bar, nb * 6);
    phase6(p, lds, tid);
    grid_barrier(bar, nb * 7);
    phase8(p, tid);
}

extern "C" void kernel_launch(void* const* d_in, const int* in_sizes, int n_in, void* d_out, int out_size, void* d_ws, size_t ws_size, hipStream_t stream) {
    static int grid_blocks = 0;
    if (!grid_blocks) {
        int dev = 0, cus = 0, per_cu = 0;
        (void)hipGetDevice(&dev);
        (void)hipDeviceGetAttribute(&cus, hipDeviceAttributeMultiprocessorCount, dev);
        (void)hipFuncSetAttribute((const void*)fwd_megakernel, hipFuncAttributeMaxDynamicSharedMemorySize, LDS_BYTES);
        (void)hipOccupancyMaxActiveBlocksPerMultiprocessor(&per_cu, (const void*)fwd_megakernel, 256, LDS_BYTES);
        if (per_cu > 2) per_cu = 2;
        if (per_cu < 1) per_cu = 1;
        grid_blocks = cus * per_cu;
        if (ws_size < WS_END) fprintf(stderr, "kernel_launch: workspace too small: %zu < %zu\n", ws_size, (size_t)WS_END);
    }
    if (ws_size < WS_END) return;
    Params p{};
    for (int i = 0; i < 27; ++i) p.in[i] = (const float*)d_in[i];
    p.out = (float*)d_out;
    p.ws = (unsigned char*)d_ws;
    (void)hipMemsetAsync((unsigned char*)d_ws + OFF_BAR, 0, 256, stream);
    void* args[] = {&p};
    hipError_t e = hipLaunchCooperativeKernel((const void*)fwd_megakernel, dim3(grid_blocks), dim3(256), args, LDS_BYTES, stream);
    if (e != hipSuccess) fprintf(stderr, "cooperative launch failed: %s (grid %d)\n", hipGetErrorString(e), grid_blocks);
}
```
